# Optimizing an MI355X kernel written in HIP

```python
import math
import jax, jax.numpy as jnp
from jax import lax
import numpy as np

D_MODEL = 1024
BATCH = 8
SEQ = 4096
DEPTH = 2

ATTN_WIDTH = D_MODEL // 2
HEAD_DIM = 64
N_ATTN_HEADS = ATTN_WIDTH // HEAD_DIM
DILATED_PATTERNS = ((128, 1), (512, 4), (2048, 16))
REL_BUCKETS = 32
REL_MAX_DISTANCE = 1024
SSM_WIDTH = D_MODEL - ATTN_WIDTH
SSM_GROUP = 16
SSM_GROUPS = SSM_WIDTH // SSM_GROUP
SSM_STATE = 64
STEP_MIN = 1e-3
STEP_MAX = 1e-1
PEER_HEADS = 8
PEER_KEYS = 128
PEER_EXPERTS = PEER_KEYS * PEER_KEYS
PEER_QUERY_DIM = 128
PEER_TOPK = 16
PEER_CHUNK = 128
EPS = 1e-6
NEG_INF = -1e30

kernel_name = "hybrid_dilated_attn_s5_peer_encoder"


def _rmsnorm(x, g):
    x32 = x.astype(jnp.float32)
    y = x32 * lax.rsqrt(jnp.mean(x32 * x32, axis=-1, keepdims=True) + EPS) * g.astype(jnp.float32)
    return y.astype(x.dtype)


def _t5_buckets(rel):
    half = REL_BUCKETS // 2
    max_exact = half // 2
    n = np.abs(rel)
    large = max_exact + (np.log(np.maximum(n, 1) / max_exact)
                         / np.log(REL_MAX_DISTANCE / max_exact) * (half - max_exact)).astype(np.int32)
    large = np.minimum(large, half - 1)
    return (np.where(rel > 0, half, 0) + np.where(n < max_exact, n, large)).astype(np.int32)


def _band_structure(length, dilation, half):
    blk = half
    nb = -(-length // blk)
    ql = np.arange(blk)[:, None]
    t = np.arange(3 * blk)[None, :]
    delta = t - blk - ql
    key_pos = (np.arange(nb)[:, None, None] - 1) * blk + t[None]
    valid = (np.abs(delta)[None] <= half) & (key_pos >= 0) & (key_pos < length)
    buckets = _t5_buckets(delta * dilation)
    return nb, valid, buckets


def _dilated_band_attention(q, k, v, rel_bias, window, dilation):
    bsz, seq, heads, hd = q.shape
    half = window // (2 * dilation)
    blk = half
    length = seq // dilation
    nb, valid, buckets = _band_structure(length, dilation, half)
    pad = nb * blk - length

    def to_sub(t):
        return t.reshape(bsz, length, dilation, heads, hd).transpose(0, 2, 3, 1, 4)

    qs = jnp.pad(to_sub(q), ((0, 0), (0, 0), (0, 0), (0, pad), (0, 0)))
    qs = qs.reshape(bsz, dilation, heads, nb, blk, hd)

    def windows(t):
        tp = jnp.pad(to_sub(t), ((0, 0), (0, 0), (0, 0), (blk, pad + blk), (0, 0)))
        tp = tp.reshape(bsz, dilation, heads, nb + 2, blk, hd)
        return jnp.concatenate([tp[:, :, :, :-2], tp[:, :, :, 1:-1], tp[:, :, :, 2:]], axis=4)

    kw, vw = windows(k), windows(v)
    bias = jnp.transpose(rel_bias[buckets], (2, 0, 1)).astype(jnp.float32)
    logits = jnp.einsum('brhnqd,brhnkd->brhnqk', qs, kw,
                        preferred_element_type=jnp.float32) * (hd ** -0.5)
    logits = jnp.where(valid[None, None, None], logits + bias[None, None, :, None], NEG_INF)
    m = jnp.max(logits, axis=-1, keepdims=True)
    p = jnp.exp(logits - m)
    s = jnp.sum(p, axis=-1, keepdims=True)
    o = jnp.einsum('brhnqk,brhnkd->brhnqd', p, vw.astype(jnp.float32)) / s
    lse = (m + jnp.log(s))[..., 0]

    o = o.reshape(bsz, dilation, heads, nb * blk, hd)[:, :, :, :length]
    o = o.transpose(0, 3, 1, 2, 4).reshape(bsz, seq, heads, hd)
    lse = lse.reshape(bsz, dilation, heads, nb * blk)[:, :, :, :length]
    lse = lse.transpose(0, 3, 1, 2).reshape(bsz, seq, heads)
    return o, lse


def _dilated_attention_mixture(q, k, v, rel_bias):
    outs, lses = zip(*[_dilated_band_attention(q, k, v, rel_bias, w, d) for w, d in DILATED_PATTERNS])
    weights = jax.nn.softmax(jnp.stack(lses), axis=0)
    return jnp.sum(weights[..., None] * jnp.stack(outs), axis=0)


def _ssm_combine(e_i, e_j):
    a_i, b_i = e_i
    a_j, b_j = e_j
    return a_j * a_i, a_j * b_i + b_j


def _s5_bidirectional(u, lam_re, lam_im, log_step, b_re, b_im, c_re, c_im, d_skip):
    bsz, seq, _ = u.shape
    f32 = jnp.float32
    u_g = u.astype(f32).reshape(bsz, seq, SSM_GROUPS, SSM_GROUP)
    lam = lax.complex(lam_re.astype(f32), lam_im.astype(f32))
    step = jnp.exp(log_step.astype(f32))[..., None]
    lam_bar = jnp.exp(lam * step)
    b = lax.complex(b_re.astype(f32), b_im.astype(f32))
    b_bar = ((lam_bar - 1.0) / lam)[..., None] * b
    c = lax.complex(c_re.astype(f32), c_im.astype(f32))
    u_c = u_g.astype(jnp.complex64)
    y = d_skip.astype(f32).reshape(SSM_GROUPS, SSM_GROUP) * u_g
    for direction, rev in ((0, False), (1, True)):
        bu = jnp.einsum('bsgc,gpc->bsgp', u_c, b_bar[direction])
        a = jnp.broadcast_to(lam_bar[direction], (1, seq, SSM_GROUPS, SSM_STATE))
        _, states = lax.associative_scan(_ssm_combine, (a, bu), axis=1, reverse=rev)
        y = y + jnp.einsum('bsgp,gcp->bsgc', states, c[direction]).real
    return y.reshape(bsz, seq, SSM_WIDTH)


def _peer(h, w_query, sub_keys, expert_u, expert_v):
    bsz, seq, dm = h.shape
    f32 = jnp.float32
    q = (h @ w_query).reshape(bsz, seq, PEER_HEADS, PEER_QUERY_DIM)
    half = PEER_QUERY_DIM // 2
    s1 = jnp.einsum('bshk,hnk->bshn', q[..., :half], sub_keys[0], preferred_element_type=f32)
    s2 = jnp.einsum('bshk,hnk->bshn', q[..., half:], sub_keys[1], preferred_element_type=f32)
    t1, i1 = lax.top_k(s1, PEER_TOPK)
    t2, i2 = lax.top_k(s2, PEER_TOPK)
    cand = (t1[..., :, None] + t2[..., None, :]).reshape(bsz, seq, PEER_HEADS, PEER_TOPK * PEER_TOPK)
    top_s, top_c = lax.top_k(cand, PEER_TOPK)
    e1 = jnp.take_along_axis(i1, top_c // PEER_TOPK, axis=-1)
    e2 = jnp.take_along_axis(i2, top_c % PEER_TOPK, axis=-1)
    experts = e1 * PEER_KEYS + e2
    gates = jax.nn.softmax(top_s, axis=-1)
    n_chunk = (bsz * seq) // PEER_CHUNK
    sel = PEER_HEADS * PEER_TOPK
    hc = h.reshape(n_chunk, PEER_CHUNK, dm)
    ec = experts.reshape(n_chunk, PEER_CHUNK, sel)
    gc = gates.reshape(n_chunk, PEER_CHUNK, sel)

    def chunk(args):
        h_c, e_c, g_c = args
        act = jax.nn.gelu(jnp.einsum('td,ted->te', h_c, expert_u[e_c], preferred_element_type=f32),
                          approximate=False)
        out = jnp.einsum('te,ted->td', g_c * act, expert_v[e_c].astype(f32))
        return out.astype(h.dtype)

    return lax.map(chunk, (hc, ec, gc)).reshape(bsz, seq, dm)


def setup_inputs(seed: int = 0) -> dict:
    key = jax.random.key(seed)
    ks = jax.random.split(key, 24)
    f32 = jnp.float32

    def nrm(k, shape, scale):
        return jax.random.normal(k, shape, f32) * scale

    mix_in = 3 * ATTN_WIDTH + SSM_WIDTH
    ssm_shape = (DEPTH, 2, SSM_GROUPS, SSM_STATE)
    return {
        "x": nrm(ks[0], (BATCH, SEQ, D_MODEL), 1.0),
        "w_in": nrm(ks[1], (DEPTH, D_MODEL, mix_in), D_MODEL ** -0.5),
        "w_out": nrm(ks[2], (DEPTH, D_MODEL, D_MODEL), D_MODEL ** -0.5),
        "rel_bias": nrm(ks[3], (REL_BUCKETS, N_ATTN_HEADS), 0.5),
        "g_attn": 1.0 + nrm(ks[4], (DEPTH, ATTN_WIDTH), 0.05),
        "g_ssm": 1.0 + nrm(ks[5], (DEPTH, SSM_WIDTH), 0.05),
        "norm_mix": 1.0 + nrm(ks[6], (DEPTH, D_MODEL), 0.05),
        "norm_ffn": 1.0 + nrm(ks[7], (DEPTH, D_MODEL), 0.05),
        "lam_re": -0.5 + nrm(ks[8], ssm_shape, 0.01),
        "lam_im": math.pi * jnp.arange(SSM_STATE, dtype=f32) + nrm(ks[9], ssm_shape, 0.01),
        "log_step": jax.random.uniform(ks[10], (DEPTH, 2, SSM_GROUPS), f32,
                                       minval=math.log(STEP_MIN), maxval=math.log(STEP_MAX)),
        "b_re": nrm(ks[11], (DEPTH, 2, SSM_GROUPS, SSM_STATE, SSM_GROUP), (2 * SSM_GROUP) ** -0.5),
        "b_im": nrm(ks[12], (DEPTH, 2, SSM_GROUPS, SSM_STATE, SSM_GROUP), (2 * SSM_GROUP) ** -0.5),
        "c_re": nrm(ks[13], (DEPTH, 2, SSM_GROUPS, SSM_GROUP, SSM_STATE), (2 * SSM_STATE) ** -0.5),
        "c_im": nrm(ks[14], (DEPTH, 2, SSM_GROUPS, SSM_GROUP, SSM_STATE), (2 * SSM_STATE) ** -0.5),
        "d_skip": nrm(ks[15], (DEPTH, SSM_WIDTH), 1.0),
        "w_glu": nrm(ks[16], (DEPTH, SSM_WIDTH, 2 * SSM_WIDTH), SSM_WIDTH ** -0.5),
        "w_query": nrm(ks[17], (DEPTH, D_MODEL, PEER_HEADS * PEER_QUERY_DIM), D_MODEL ** -0.5),
        "sub_keys": nrm(ks[18], (DEPTH, 2, PEER_HEADS, PEER_KEYS, PEER_QUERY_DIM // 2),
                         (PEER_QUERY_DIM // 2) ** -0.5),
        "expert_u": nrm(ks[19], (DEPTH, PEER_EXPERTS, D_MODEL), D_MODEL ** -0.5),
        "expert_v": nrm(ks[20], (DEPTH, PEER_EXPERTS, D_MODEL), PEER_HEADS ** -0.5),
        "norm_final": 1.0 + nrm(ks[21], (D_MODEL,), 0.05),
    }


def reference(x, w_in, w_out, rel_bias, g_attn, g_ssm, norm_mix, norm_ffn, lam_re, lam_im,
              log_step, b_re, b_im, c_re, c_im, d_skip, w_glu, w_query, sub_keys,
              expert_u, expert_v, norm_final):
    bsz, seq, _ = x.shape
    for l in range(DEPTH):
        h = _rmsnorm(x, norm_mix[l])
        proj = h @ w_in[l]
        q = proj[..., :ATTN_WIDTH].reshape(bsz, seq, N_ATTN_HEADS, HEAD_DIM)
        k = proj[..., ATTN_WIDTH:2 * ATTN_WIDTH].reshape(bsz, seq, N_ATTN_HEADS, HEAD_DIM)
        v = proj[..., 2 * ATTN_WIDTH:3 * ATTN_WIDTH].reshape(bsz, seq, N_ATTN_HEADS, HEAD_DIM)
        u = proj[..., 3 * ATTN_WIDTH:]

        attn = _dilated_attention_mixture(q, k, v, rel_bias)
        attn = attn.reshape(bsz, seq, ATTN_WIDTH).astype(x.dtype)

        y = jax.nn.gelu(_s5_bidirectional(u, lam_re[l], lam_im[l], log_step[l], b_re[l], b_im[l],
                                          c_re[l], c_im[l], d_skip[l]).astype(x.dtype),
                        approximate=False)
        ab = y @ w_glu[l]
        ssm = ab[..., :SSM_WIDTH] * jax.nn.sigmoid(ab[..., SSM_WIDTH:])

        mix = jnp.concatenate([_rmsnorm(attn, g_attn[l]), _rmsnorm(ssm, g_ssm[l])], axis=-1)
        x = x + mix @ w_out[l]

        x = x + _peer(_rmsnorm(x, norm_ffn[l]), w_query[l], sub_keys[l], expert_u[l], expert_v[l])
    return _rmsnorm(x, norm_final)
```

```cpp
#include <hip/hip_runtime.h>
#include <cmath>
#include <cstdio>
#include <cstring>
#include <type_traits>

#define LAS __attribute__((address_space(3)))
#define GAS __attribute__((address_space(1)))
typedef unsigned short bf16_t;
typedef short bf16x8 __attribute__((ext_vector_type(8)));
typedef short s16x4 __attribute__((ext_vector_type(4)));
typedef float f32x4 __attribute__((ext_vector_type(4)));
typedef float f32x2 __attribute__((ext_vector_type(2)));
typedef float f32x16 __attribute__((ext_vector_type(16)));
typedef unsigned u32x4 __attribute__((ext_vector_type(4)));
typedef unsigned u32x2 __attribute__((ext_vector_type(2)));
typedef int i32x4 __attribute__((ext_vector_type(4)));
typedef __bf16 bf16x2_t __attribute__((ext_vector_type(2)));

constexpr int NB = 8, SEQ = 4096, DM = 1024, TOK = NB * SEQ, NLAYER = 2;
constexpr int AW = 512, NH = 8, HD = 64, SW = 512, SG = 32, SC = 16, SP = 64;
constexpr int CL = 32;
constexpr int NCHUNK = SEQ / CL;
constexpr int ROWS_G = NB * NCHUNK;
constexpr int K2 = CL * SC + 4 * SP;
constexpr int N2 = CL * SC;
constexpr int K1 = CL * SC;
constexpr int N1 = 4 * SP;
constexpr int PH = 8, PKEYS = 128, PQD = 128, PTOP = 16, NEXP = PKEYS * PKEYS, PSEL = PH * PTOP;
constexpr float EPS = 1e-6f;
constexpr float LOG2E = 1.4426950408889634f, LN2 = 0.6931471805599453f;

constexpr size_t MiB = 1u << 20;
constexpr size_t WS_CTL = 0, CTL_ZERO_BYTES = 64 * 1024;
constexpr size_t WS_SK = 1 * MiB;
constexpr size_t WS_LAML = 1 * MiB + 512 * 1024;
constexpr size_t WS_ESC = 1 * MiB + 640 * 1024;
constexpr size_t WS_HSC = 1 * MiB + 768 * 1024;
constexpr size_t WS_WSC = 1 * MiB + 896 * 1024;
constexpr size_t WS_WMAX = 16 * 1024;
constexpr int WSC_IN = 0, WSC_OUT = 2 * 2048, WSC_Q = 2 * 2048 + 2 * 1024;
constexpr size_t WS_WIN = 2 * MiB;
constexpr size_t WS_WGLU = 10 * MiB;
constexpr size_t WS_WOUT = 12 * MiB;
constexpr size_t WS_WQ = 16 * MiB;
constexpr size_t WS_W1 = 20 * MiB;
constexpr size_t WS_M2 = 36 * MiB;
constexpr size_t WS_EU = 84 * MiB;
constexpr size_t WS_EV = 100 * MiB;
constexpr size_t WS_H = 116 * MiB;
constexpr size_t WS_XB = 148 * MiB;
constexpr size_t WS_Q = 212 * MiB, WS_K = 244 * MiB, WS_V = 276 * MiB;
constexpr size_t WS_QB = 212 * MiB;
constexpr size_t WS_EID = 276 * MiB, WS_GATE = 292 * MiB;
constexpr size_t WS_UX = 308 * MiB;
constexpr size_t WS_SSM = 308 * MiB;
constexpr size_t WS_E = 356 * MiB;
constexpr size_t WS_Y = 116 * MiB;
constexpr size_t WS_OP = 388 * MiB;
constexpr size_t WS_LSE = 484 * MiB;
constexpr size_t WS_END = 487 * MiB;

constexpr int RING_BYTES = 131072;
constexpr int LDS_BYTES = 163840;
constexpr int MISC_OFF = LDS_BYTES - 512;
constexpr int NWAVES = 8, NTHREADS = 512;

__device__ __forceinline__ unsigned f2bf(float f) { unsigned u = __builtin_bit_cast(unsigned, f); return (u + 0x7fffu + ((u >> 16) & 1u)) >> 16; }
__device__ __forceinline__ unsigned pk2(float lo, float hi) { f32x2 v = {lo, hi}; bf16x2_t b = __builtin_convertvector(v, bf16x2_t); return __builtin_bit_cast(unsigned, b); }
__device__ __forceinline__ float bflo(unsigned w) { return __builtin_bit_cast(float, w << 16); }
__device__ __forceinline__ float bfhi(unsigned w) { return __builtin_bit_cast(float, w & 0xffff0000u); }
template <int CTRL> __device__ __forceinline__ float dppf(float v) { return __builtin_bit_cast(float, __builtin_amdgcn_update_dpp(0, __builtin_bit_cast(int, v), CTRL, 0xf, 0xf, false)); }
__device__ __forceinline__ float wave_sum(float v) {
    v += dppf<0xB1>(v); v += dppf<0x4E>(v); v += dppf<0x141>(v); v += dppf<0x140>(v);
    v += __shfl_xor(v, 16); v += __shfl_xor(v, 32);
    return v;
}
__device__ __forceinline__ float gelu1(float v) {
    const float av = fabsf(v), d = av * 0.2316418882f + 1.0f;
    const float t = __builtin_amdgcn_rcpf(d);
    float q = t * 0.5307027145f + (-0.7265760135f); q = q * t + 0.7107068705f; q = q * t + (-0.142248368f); q = q * t + 0.127414796f; q = q * t;
    const float e = __builtin_amdgcn_exp2f((v * v) * (-0.72134752044f));
    const float m = v * (q * e);
    return v < 0.f ? m : v - m;
}

#define XB_TMO      128
#define XB_XCNT(j)  (256  + 64 * (j))
#define XB_XSUB(j)  (1280 + 64 * (j))
#define XB_XGEN(j)  (2304 + 64 * (j))
#define XB_TOP      3328
#define XB_TOPGEN   3392
#define XCD_BAR_WORDS 3456
#define XB_SPIN_CAP (1u << 22)
__device__ __forceinline__ unsigned xb_ld(unsigned* p)              { return __hip_atomic_load(p, __ATOMIC_RELAXED, __HIP_MEMORY_SCOPE_AGENT); }
__device__ __forceinline__ unsigned xb_add(unsigned* p, unsigned v) { return __hip_atomic_fetch_add(p, v, __ATOMIC_RELAXED, __HIP_MEMORY_SCOPE_AGENT); }
__device__ __forceinline__ unsigned xb_xcc_id() { return (unsigned)__builtin_amdgcn_s_getreg((3 << 11) | 20) & 0xFu; }
#define XB_SPIN(cond, bar) do { unsigned _sp = 0; while (cond) { __builtin_amdgcn_s_sleep(1); \
    if ((++_sp & 255u) == 0u) { if (xb_ld(&(bar)[XB_TMO])) break; if (_sp > XB_SPIN_CAP) { atomicAdd(&(bar)[XB_TMO], 1u); break; } } } } while (0)
__device__ __forceinline__ int lane_id() { int r; asm volatile("v_mbcnt_lo_u32_b32 %0, -1, 0\n\tv_mbcnt_hi_u32_b32 %0, -1, %0" : "=v"(r)); return r; }
struct XcdBarrier { unsigned* bar; unsigned x; volatile LAS unsigned* st; int wv; };
__device__ __forceinline__ XcdBarrier xcd_barrier_post(unsigned* bar, volatile LAS unsigned* st, int wv) {
    XcdBarrier b; b.bar = bar; b.x = xb_xcc_id(); b.st = st; b.wv = wv;
    if (wv == 0 && lane_id() == 0) (void)xb_add(&bar[XB_XCNT(b.x)], 1u);
    return b;
}
__device__ __forceinline__ void xcd_barrier_complete(unsigned* bar, unsigned x, unsigned& nloc, unsigned& nx) {
    const unsigned G = gridDim.x * gridDim.y * gridDim.z;
    unsigned sum, cnt, mine, sp = 0u;
    for (;;) {
        sum = 0u; cnt = 0u; mine = 0u;
#pragma unroll
        for (unsigned j = 0; j < 16; ++j) { const unsigned c = xb_ld(&bar[XB_XCNT(j)]); sum += c; cnt += (c > 0u) ? 1u : 0u; mine = (j == x) ? c : mine; }
        if (sum == G) break;
        __builtin_amdgcn_s_sleep(1);
        if ((++sp & 255u) == 0u) { if (xb_ld(&bar[XB_TMO])) break; if (sp > XB_SPIN_CAP) { atomicAdd(&bar[XB_TMO], 1u); break; } }
    }
    nloc = mine > 0u ? mine : 1u; nx = cnt > 0u ? cnt : 1u;
}
__device__ __forceinline__ void xcd_barrier(const XcdBarrier& b) {
    asm volatile("s_waitcnt vmcnt(0)" ::: "memory");
    __syncthreads();
    if (b.wv == 0 && lane_id() == 0) {
        unsigned* bar = b.bar;
        __builtin_amdgcn_s_waitcnt(0);
        unsigned nloc = b.st[0], nx = b.st[1];
        if (nloc == 0u) { xcd_barrier_complete(bar, b.x, nloc, nx); b.st[0] = nloc; b.st[1] = nx; }
        const unsigned old = xb_add(&bar[XB_XSUB(b.x)], 1u);
        const unsigned gen = old / nloc;
        if (old + 1u == (gen + 1u) * nloc) {
            __builtin_amdgcn_fence(__ATOMIC_RELEASE, "agent");
            asm volatile("s_waitcnt vmcnt(0)" ::: "memory");
            const unsigned og = xb_add(&bar[XB_TOP], 1u);
            const unsigned tg = og / nx;
            if (og + 1u == (tg + 1u) * nx) xb_add(&bar[XB_TOPGEN], 1u);
            else XB_SPIN(xb_ld(&bar[XB_TOPGEN]) == tg, bar);
            __builtin_amdgcn_fence(__ATOMIC_ACQUIRE, "agent");
            xb_add(&bar[XB_XGEN(b.x)], 1u);
            asm volatile("s_waitcnt vmcnt(0)" ::: "memory");
        } else {
            XB_SPIN(xb_ld(&bar[XB_XGEN(b.x)]) == gen, bar);
            __builtin_amdgcn_fence(__ATOMIC_ACQUIRE, "agent");
            asm volatile("s_waitcnt vmcnt(0)" ::: "memory");
        }
    }
    __syncthreads();
}

namespace pg8 {
constexpr int BM = 256, BK = 64, HALF = 128, HTB = HALF * BK * 2, STAGE_BYTES = 8 * HTB, NXCD = 8, WGM = 8;
__host__ __device__ __forceinline__ int lds_byte(int r, int c) { const int st = (r >> 4) * 2 + (c >> 5), rr = r & 15, cc = c & 31, ob = rr * 64 + cc * 2; return st * 1024 + (ob ^ (((ob >> 9) & 1) << 5)); }
__host__ __device__ __forceinline__ void stage_rc(int b, int& R, int& C) { const int st = b / 1024, sb = b % 1024, swz = sb ^ (((sb >> 9) & 1) << 5); R = (st >> 1) * 16 + swz / 64; C = (st & 1) * 32 + (swz % 64) / 2; }
__host__ __device__ __forceinline__ int perm32(int rho) { const int n = rho >> 4, i = rho & 15; return 8 * (i >> 2) + 4 * n + (i & 3); }
__host__ __device__ __forceinline__ int perm2(int R) { return 64 * (R >> 5) + 16 * ((R >> 2) & 3) + 4 * ((R >> 4) & 1) + (R & 3); }
struct Unit { int pm, pn; };
struct Gemm { const bf16_t* A; const bf16_t* Bt; int lda, ldb, K; };
struct StaticOrder {
    int nM, nN, nwg, G, c;
    __device__ void init(int M, int N, int G_, int c_) { nM = M / BM; nN = N / BM; nwg = nM * nN; G = G_; c = c_; }
    __device__ bool next(int i, Unit& u) const {
        const long L = (long)i * G + c; if (L >= nwg) return false;
        int wgid = (int)L; { const int q = nwg / NXCD, r = nwg % NXCD, xcd = wgid % NXCD, off = wgid / NXCD; wgid = (xcd < r ? xcd * (q + 1) : r * (q + 1) + (xcd - r) * q) + off; }
        const int nig = WGM * nN, gid = wgid / nig, fm = gid * WGM, gsz = (nM - fm) < WGM ? (nM - fm) : WGM;
        u.pm = fm + ((wgid % nig) % gsz); u.pn = (wgid % nig) / gsz; return true;
    }
    __device__ __forceinline__ void a_ready(const Unit&) const {}
    __device__ __forceinline__ void done(const Unit&) const {}
};
struct BatchOrder {
    int nMl, nNl, ngrp, G, c;
    __device__ void init(int nMl_, int nNl_, int ngrp_, int G_, int c_) { nMl = nMl_; nNl = nNl_; ngrp = ngrp_; G = G_; c = c_; }
    __device__ bool next(int i, Unit& u) const {
        const long L = (long)i * G + c; if (L >= (long)ngrp * nMl * nNl) return false;
        const int per = nMl * nNl, g = (int)L / per, r = (int)L % per;
        u.pm = g * nMl + r / nNl; u.pn = g * nNl + r % nNl; return true;
    }
    __device__ __forceinline__ void a_ready(const Unit&) const {}
    __device__ __forceinline__ void done(const Unit&) const {}
};

__device__ __forceinline__ f32x4 mma16(bf16x8 a, bf16x8 b, f32x4 c) { return __builtin_amdgcn_mfma_f32_16x16x32_bf16(a, b, c, 0, 0, 0); }
__device__ __forceinline__ i32x4 mma16(bf16x8 a, bf16x8 b, i32x4 c) { return __builtin_amdgcn_mfma_i32_16x16x64_i8(__builtin_bit_cast(i32x4, a), __builtin_bit_cast(i32x4, b), c, 0, 0, 0); }
struct LocalPairOrder {
    int G, c;
    __device__ void init(int G_, int c_) { G = G_; c = c_; }
    __device__ bool next(int i, Unit& u) const {
        const int L = c + (i >> 1) * G; if (L >= 128) return false;
        u.pm = L; u.pn = (L >> 2) * 2 + (i & 1); return true;
    }
    __device__ __forceinline__ void a_ready(const Unit&) const {}
    __device__ __forceinline__ void done(const Unit&) const {}
};
template <class Epi, class Sched>
__device__ __forceinline__ void gemm_phase(LAS unsigned char* lds, const int tid, const Gemm g, const Sched& S, const Epi& E) {
    typedef typename std::conditional<Epi::I8, i32x4, f32x4>::type AccV;
    const int wid = __builtin_amdgcn_readfirstlane(tid >> 6), lane = tid & 63, wr = wid >> 2, wc = wid & 3, fr = lane & 15, fq = lane >> 4;
    const int K = g.K, nt = K / BK;
    unsigned voffA[2], voffB[2];
#pragma unroll
    for (int i = 0; i < 2; ++i) { int R, C; stage_rc(tid * 16 + i * 8192, R, C); const int Rb = Epi::PERM == 2 ? perm2(R) : Epi::PERM == 1 ? ((R & ~31) + perm32(R & 31)) : R;
        voffA[i] = (unsigned)(R * g.lda + C) * 2u; voffB[i] = (unsigned)(Rb * g.ldb + C) * 2u; }
    const size_t kstep = (size_t)(BK * 2);
    const size_t hA = (size_t)HALF * g.lda * 2, hB = (size_t)(Epi::PERM == 2 ? 8 : HALF) * g.ldb * 2;
    const size_t tA = 2 * hA, tB = (size_t)BM * g.ldb * 2;
    const unsigned ldsw = (unsigned)wid * 1024u;
    const int aoff = lds_byte(wr * 64 + fr, fq * 8), boff = lds_byte(wc * 32 + fr, fq * 8);
#define PG8_SA(b, h) (((b) * 2 + (h)) * HTB)
#define PG8_SB(b, h) ((4 + (b) * 2 + (h)) * HTB)
#define PG8_STAGE(bufoff, gbase, voff) do { _Pragma("unroll") for (int _i = 0; _i < 2; ++_i) \
        __builtin_amdgcn_global_load_lds((const unsigned*)((const char*)(gbase) + (voff)[_i]), (LAS unsigned*)(lds + (bufoff) + ldsw + _i * 8192), 16, 0, 0); } while (0)
#define PG8_LDA(dst, b, h) do { _Pragma("unroll") for (int m = 0; m < 4; ++m) _Pragma("unroll") for (int k = 0; k < 2; ++k) dst[m][k] = *(const LAS bf16x8*)(lds + PG8_SA(b, h) + aoff + m * 2048 + k * 1024); } while (0)
#define PG8_LDB(dst, b, h) do { _Pragma("unroll") for (int n = 0; n < 2; ++n) _Pragma("unroll") for (int k = 0; k < 2; ++k) dst[n][k] = *(const LAS bf16x8*)(lds + PG8_SB(b, h) + boff + n * 2048 + k * 1024); } while (0)
#define PG8_MMA(ai, bj, At, Bt) do { __builtin_amdgcn_s_setprio(1); _Pragma("unroll") for (int m = 0; m < 4; ++m) _Pragma("unroll") for (int n = 0; n < 2; ++n) _Pragma("unroll") for (int k = 0; k < 2; ++k) \
        acc[ai][bj][m][n] = mma16(Bt[n][k], At[m][k], acc[ai][bj][m][n]); __builtin_amdgcn_s_setprio(0); } while (0)
#define PG8_WAIT_V(n) asm volatile("s_waitcnt vmcnt(" #n ")" ::: "memory")
#define PG8_WAIT_L(n) asm volatile("s_waitcnt lgkmcnt(" #n ")" ::: "memory")
#define PG8_BAR __builtin_amdgcn_s_barrier()
#define PG8_SCHED __builtin_amdgcn_sched_barrier(0)
    Unit cur, nxt; int ui = 0;
    if (!S.next(0, cur)) return;
    AccV acc[2][2][4][2];
#pragma unroll
    for (int a = 0; a < 2; ++a)
#pragma unroll
        for (int b = 0; b < 2; ++b)
#pragma unroll
            for (int m = 0; m < 4; ++m)
#pragma unroll
                for (int n = 0; n < 2; ++n) acc[a][b][m][n] = (AccV){0, 0, 0, 0};
    bf16x8 At[4][2], B0[2][2], B1[2][2];
    const char* cA = (const char*)g.A + (size_t)cur.pm * tA; const char* cB = (const char*)g.Bt + (size_t)cur.pn * tB;
    S.a_ready(cur);
    PG8_STAGE(PG8_SB(0, 0), cB, voffB); PG8_STAGE(PG8_SA(0, 0), cA, voffA); PG8_STAGE(PG8_SB(0, 1), cB + hB, voffB); PG8_STAGE(PG8_SA(0, 1), cA + hA, voffA);
    if (wr == 1) PG8_BAR;
    PG8_WAIT_V(4); PG8_BAR;
    PG8_STAGE(PG8_SB(1, 0), cB + kstep, voffB); PG8_STAGE(PG8_SA(1, 0), cA + kstep, voffA); PG8_STAGE(PG8_SB(1, 1), cB + hB + kstep, voffB);
    PG8_WAIT_V(6); PG8_BAR;
    for (;;) {
        const bool has_next = S.next(ui + 1, nxt);
        const char* nA = has_next ? (const char*)g.A + (size_t)nxt.pm * tA : cA; const char* nB = has_next ? (const char*)g.Bt + (size_t)nxt.pn * tB : cB;
        for (int t = 0; t < nt; t += 2) {
            const bool last = (t == nt - 2);
            const char* a1 = cA + (size_t)(t + 1) * kstep;
            const char* a2 = last ? nA : cA + (size_t)(t + 2) * kstep; const char* b2 = last ? nB : cB + (size_t)(t + 2) * kstep;
            const char* a3 = a2 + kstep; const char* b3 = b2 + kstep;
            if (last && has_next) S.a_ready(nxt);
            PG8_LDB(B0, 0, 0); PG8_SCHED; PG8_LDA(At, 0, 0); PG8_STAGE(PG8_SA(1, 1), a1 + hA, voffA);
            PG8_WAIT_L(8); PG8_BAR; PG8_WAIT_L(0); PG8_MMA(0, 0, At, B0); PG8_BAR; PG8_SCHED;
            PG8_LDB(B1, 0, 1); PG8_STAGE(PG8_SB(0, 0), b2, voffB);
            PG8_BAR; PG8_WAIT_L(0); PG8_MMA(0, 1, At, B1); PG8_BAR;
            PG8_LDA(At, 0, 1); PG8_STAGE(PG8_SA(0, 0), a2, voffA);
            PG8_BAR; PG8_WAIT_L(0); PG8_MMA(1, 0, At, B0); PG8_BAR; PG8_SCHED;
            PG8_STAGE(PG8_SB(0, 1), b2 + hB, voffB);
            PG8_WAIT_V(6); PG8_BAR; PG8_MMA(1, 1, At, B1); PG8_BAR;
            PG8_LDB(B0, 1, 0); PG8_SCHED; PG8_LDA(At, 1, 0); PG8_STAGE(PG8_SA(0, 1), a2 + hA, voffA);
            PG8_WAIT_L(8); PG8_BAR; PG8_WAIT_L(0); PG8_MMA(0, 0, At, B0); PG8_BAR; PG8_SCHED;
            PG8_LDB(B1, 1, 1); PG8_STAGE(PG8_SB(1, 0), b3, voffB);
            PG8_BAR; PG8_WAIT_L(0); PG8_MMA(0, 1, At, B1); PG8_BAR;
            PG8_LDA(At, 1, 1); PG8_STAGE(PG8_SA(1, 0), a3, voffA);
            PG8_BAR; PG8_WAIT_L(0); PG8_MMA(1, 0, At, B0); PG8_BAR; PG8_SCHED;
            PG8_STAGE(PG8_SB(1, 1), b3 + hB, voffB);
            PG8_WAIT_V(6); PG8_BAR; PG8_MMA(1, 1, At, B1); PG8_BAR;
        }
        E(acc, cur, wr, wc, fr, fq); S.done(cur);
        if (!has_next) break;
#pragma unroll
        for (int a = 0; a < 2; ++a)
#pragma unroll
            for (int b = 0; b < 2; ++b)
#pragma unroll
                for (int m = 0; m < 4; ++m)
#pragma unroll
                    for (int n = 0; n < 2; ++n) acc[a][b][m][n] = (AccV){0, 0, 0, 0};
        cur = nxt; cA = nA; cB = nB; ++ui;
    }
    PG8_WAIT_V(0);
    if (wr == 0) PG8_BAR;
    PG8_BAR;
#undef PG8_SA
#undef PG8_SB
#undef PG8_STAGE
#undef PG8_LDA
#undef PG8_LDB
#undef PG8_MMA
#undef PG8_WAIT_V
#undef PG8_WAIT_L
#undef PG8_BAR
#undef PG8_SCHED
}
}

typedef f32x4 AccT[2][2][4][2];
typedef i32x4 AccI[2][2][4][2];
#define EPI_LOOP_ROWS for (int ai = 0; ai < 2; ++ai) _Pragma("unroll") for (int m = 0; m < 4; ++m)

__device__ __forceinline__ void scale16(float (&v)[16], const AccI& acc, int ai, int m, const f32x4 (&cv)[4], float rsc) {
#pragma unroll
    for (int bj = 0; bj < 2; ++bj)
#pragma unroll
        for (int n = 0; n < 2; ++n)
#pragma unroll
            for (int e = 0; e < 4; ++e) v[8 * bj + 4 * n + e] = (float)acc[ai][bj][m][n][e] * cv[2 * bj + n][e] * rsc;
}
struct EpiQKVU {
    static constexpr int PERM = 2; static constexpr bool I8 = true;
    bf16_t *Q, *Kp, *V, *UX; const float *rs, *cs;
    __device__ __forceinline__ void operator()(const AccI& acc, const pg8::Unit& u, int wr, int wc, int fr, int fq) const {
        const int row0 = u.pm * 256 + wr * 64 + fr, c = u.pn * 256 + wc * 64 + 16 * fq;
        f32x4 cv[4];
#pragma unroll
        for (int q = 0; q < 4; ++q) cv[q] = *(const f32x4*)(cs + c + 4 * q);
#pragma unroll
        EPI_LOOP_ROWS {
            const int r = row0 + ai * 128 + m * 16;
            float v[16]; scale16(v, acc, ai, m, cv, rs[r]);
            u32x4 w0, w1; w0.x = pk2(v[0], v[1]); w0.y = pk2(v[2], v[3]); w0.z = pk2(v[4], v[5]); w0.w = pk2(v[6], v[7]); w1.x = pk2(v[8], v[9]); w1.y = pk2(v[10], v[11]); w1.z = pk2(v[12], v[13]); w1.w = pk2(v[14], v[15]);
            bf16_t* dst;
            if (u.pn < 2) dst = Q + (size_t)r * AW + c;
            else if (u.pn < 4) dst = Kp + (size_t)r * AW + (c - 512);
            else if (u.pn < 6) dst = V + (size_t)r * AW + (c - 1024);
            else { const int g = (c - 1536) >> 4; dst = UX + ((size_t)(g * ROWS_G + (r >> 5)) * K2 + (r & 31) * SC); }
            *(u32x4*)dst = w0; *(u32x4*)(dst + 8) = w1;
        }
    }
};
struct EpiE {
    static constexpr int PERM = 0; static constexpr bool I8 = false;
    float* E;
    __device__ __forceinline__ void operator()(const AccT& acc, const pg8::Unit& u, int wr, int wc, int fr, int fq) const {
        const int row0 = u.pm * 256 + wr * 64 + fr, col0 = wc * 32 + 4 * fq;
#pragma unroll
        EPI_LOOP_ROWS {
            float* rowp = E + (size_t)(row0 + ai * 128 + m * 16) * N1 + col0;
#pragma unroll
            for (int bj = 0; bj < 2; ++bj)
#pragma unroll
                for (int n = 0; n < 2; ++n) *(f32x4*)(rowp + bj * 128 + n * 16) = acc[ai][bj][m][n];
        }
    }
};
struct EpiY {
    static constexpr int PERM = 1; static constexpr bool I8 = false;
    bf16_t* Y;
    __device__ __forceinline__ void operator()(const AccT& acc, const pg8::Unit& u, int wr, int wc, int fr, int fq) const {
        const int g = u.pn >> 1;
        const int rg0 = (u.pm & 3) * 256 + wr * 64 + fr, nc0 = (u.pn & 1) * 256 + wc * 32 + 8 * fq;
#pragma unroll
        EPI_LOOP_ROWS {
            const int rg = rg0 + ai * 128 + m * 16;
#pragma unroll
            for (int bj = 0; bj < 2; ++bj) {
                const int nc = nc0 + bj * 128, i = nc >> 4, c0 = nc & 15;
                const f32x4 v0 = acc[ai][bj][m][0], v1 = acc[ai][bj][m][1];
                u32x4 w; w.x = pk2(gelu1(v0[0]), gelu1(v0[1])); w.y = pk2(gelu1(v0[2]), gelu1(v0[3])); w.z = pk2(gelu1(v1[0]), gelu1(v1[1])); w.w = pk2(gelu1(v1[2]), gelu1(v1[3]));
                *(u32x4*)(Y + ((size_t)rg * CL + i) * SW + g * SC + c0) = w;
            }
        }
    }
};
struct EpiGLU {
    static constexpr int PERM = 1; static constexpr bool I8 = false;
    bf16_t* O;
    __device__ __forceinline__ void operator()(const AccT& acc, const pg8::Unit& u, int wr, int wc, int fr, int fq) const {
        const int row0 = u.pm * 256 + wr * 64 + fr, j0 = u.pn * 128 + wc * 32 + 8 * fq;
#pragma unroll
        EPI_LOOP_ROWS {
            const int r = row0 + ai * 128 + m * 16;
            float o[8];
#pragma unroll
            for (int n = 0; n < 2; ++n)
#pragma unroll
                for (int e = 0; e < 4; ++e) o[4 * n + e] = acc[ai][0][m][n][e] * __builtin_amdgcn_rcpf(1.f + __builtin_amdgcn_exp2f(-LOG2E * acc[ai][1][m][n][e]));
            u32x4 w; w.x = pk2(o[0], o[1]); w.y = pk2(o[2], o[3]); w.z = pk2(o[4], o[5]); w.w = pk2(o[6], o[7]);
            *(u32x4*)(O + (size_t)r * SW + j0) = w;
        }
    }
};
struct EpiRes {
    static constexpr int PERM = 2; static constexpr bool I8 = true;
    bf16_t* X; const float *rs, *cs; bool store;
    __device__ __forceinline__ void operator()(const AccI& acc, const pg8::Unit& u, int wr, int wc, int fr, int fq) const {
        const int row0 = u.pm * 256 + wr * 64 + fr, c = u.pn * 256 + wc * 64 + 16 * fq;
        if (!store) {
#pragma unroll
            for (int ai = 0; ai < 2; ++ai)
#pragma unroll
                for (int bj = 0; bj < 2; ++bj)
#pragma unroll
                    for (int m = 0; m < 4; ++m)
#pragma unroll
                        for (int n = 0; n < 2; ++n) asm volatile("" :: "v"(acc[ai][bj][m][n]));
            return;
        }
        f32x4 cv[4];
#pragma unroll
        for (int q = 0; q < 4; ++q) cv[q] = *(const f32x4*)(cs + c + 4 * q);
#pragma unroll
        EPI_LOOP_ROWS {
            const int r = row0 + ai * 128 + m * 16;
            bf16_t* xp = X + (size_t)r * DM + c;
            const u32x4 s0 = *(const u32x4*)xp, s1 = *(const u32x4*)(xp + 8);
            float v[16]; scale16(v, acc, ai, m, cv, rs[r]);
            u32x4 w0, w1;
#pragma unroll
            for (int k = 0; k < 4; ++k) { w0[k] = pk2(bflo(s0[k]) + v[2 * k], bfhi(s0[k]) + v[2 * k + 1]); w1[k] = pk2(bflo(s1[k]) + v[8 + 2 * k], bfhi(s1[k]) + v[8 + 2 * k + 1]); }
            *(u32x4*)xp = w0; *(u32x4*)(xp + 8) = w1;
        }
    }
};
struct EpiBf {
    static constexpr int PERM = 2; static constexpr bool I8 = true;
    bf16_t* O; int ldc; const float *rs, *cs;
    __device__ __forceinline__ void operator()(const AccI& acc, const pg8::Unit& u, int wr, int wc, int fr, int fq) const {
        const int row0 = u.pm * 256 + wr * 64 + fr, c = u.pn * 256 + wc * 64 + 16 * fq;
        f32x4 cv[4];
#pragma unroll
        for (int q = 0; q < 4; ++q) cv[q] = *(const f32x4*)(cs + c + 4 * q);
#pragma unroll
        EPI_LOOP_ROWS {
            const int r = row0 + ai * 128 + m * 16;
            float v[16]; scale16(v, acc, ai, m, cv, rs[r]);
            u32x4 w0, w1; w0.x = pk2(v[0], v[1]); w0.y = pk2(v[2], v[3]); w0.z = pk2(v[4], v[5]); w0.w = pk2(v[6], v[7]); w1.x = pk2(v[8], v[9]); w1.y = pk2(v[10], v[11]); w1.z = pk2(v[12], v[13]); w1.w = pk2(v[14], v[15]);
            bf16_t* dst = O + (size_t)r * ldc + c;
            *(u32x4*)dst = w0; *(u32x4*)(dst + 8) = w1;
        }
    }
};

struct Args {
    const float* in[22];
    float* out;
    unsigned char* ws;
    int ph_lo, ph_hi;
    signed char bkt[3][132];
    int pad;
};
static_assert(sizeof(Args) % 8 == 0, "Args size");

struct Ctx {
    LAS unsigned char* lds;
    unsigned char* ws;
    int tid, lane, wave, G, bid;
};
#define MKCTX(F, a) Ctx F; { int _t = wv * 64 + lane_id(); asm volatile("" : "+v"(_t)); size_t _z = 0; asm volatile("" : "+s"(_z)); \
    F.lds = (LAS unsigned char*)lds_raw; F.ws = (a).ws + _z; F.tid = _t; F.lane = _t & 63; F.wave = __builtin_amdgcn_readfirstlane(_t >> 6); F.G = gridDim.x; F.bid = blockIdx.x; }

template <class RowMap>
__device__ __forceinline__ void transpose_item(const float* W, int K, int N, bf16_t* WT, const RowMap& rm, LAS float* scr, int item, int lane) {
    const int nblk = N / 32, kb = item / nblk, nb = item % nblk, k0 = 64 * kb, n0 = 32 * nb;
#pragma unroll 8
    for (int i = 0; i < 32; ++i) { const int kk = 2 * i + (lane >> 5); scr[kk * 33 + (lane & 31)] = W[(size_t)(k0 + kk) * N + n0 + (lane & 31)]; }
    asm volatile("s_waitcnt lgkmcnt(0)" ::: "memory");
    const int c = lane & 7;
#pragma unroll
    for (int j = 0; j < 4; ++j) { const int n = (lane >> 3) + 8 * j; const LAS float* s = scr + (8 * c) * 33 + n;
        u32x4 o; o.x = pk2(s[0 * 33], s[1 * 33]); o.y = pk2(s[2 * 33], s[3 * 33]); o.z = pk2(s[4 * 33], s[5 * 33]); o.w = pk2(s[6 * 33], s[7 * 33]);
        *(u32x4*)(WT + (size_t)rm(n0 + n) * K + k0 + 8 * c) = o; }
    asm volatile("s_waitcnt lgkmcnt(0)" ::: "memory");
}
struct RowGlu { __device__ __forceinline__ int operator()(int n) const { const int j = n < SW ? n : n - SW; return (j >> 7) * 256 + (j & 127) + (n < SW ? 0 : 128); } };

__device__ void ssm_build_unit(const Ctx& F, const Args& a, int l, int g, int s) {
    LAS f32x2* LP = (LAS f32x2*)F.lds;
    LAS f32x2* BB = (LAS f32x2*)(F.lds + 33792);
    LAS float* KT = (LAS float*)(F.lds + 33792 + 16384);
    LAS f32x2* CQ = (LAS f32x2*)(F.lds + 33792 + 16384 + 16384);
    const float* lam_re = a.in[8]; const float* lam_im = a.in[9]; const float* log_step = a.in[10];
    const float* b_re = a.in[11]; const float* b_im = a.in[12]; const float* c_re = a.in[13]; const float* c_im = a.in[14]; const float* d_skip = a.in[15];
    __syncthreads();
    for (int e = F.tid; e < 2 * 33 * 64; e += NTHREADS) {
        const int dir = e / (33 * 64), tau = (e / 64) % 33, p = e % 64;
        const int pi = ((l * 2 + dir) * SG + g) * SP + p;
        const float st = expf(log_step[(l * 2 + dir) * SG + g]) * (float)tau;
        const float mag = expf(lam_re[pi] * st);
        float sn, cs; sincosf(lam_im[pi] * st, &sn, &cs);
        const f32x2 v = (f32x2){mag * cs, mag * sn};
        LP[e] = v;
        if (tau == 32 && s == 0) ((f32x2*)(F.ws + WS_LAML))[pi] = v;
    }
    for (int e = F.tid; e < 2 * 64 * 16; e += NTHREADS) {
        const int dir = e / 1024, p = (e / 16) % 64, c = e % 16;
        const int pi = ((l * 2 + dir) * SG + g) * SP + p;
        const double st = exp((double)log_step[(l * 2 + dir) * SG + g]);
        const double lr = lam_re[pi], li = lam_im[pi];
        double sn, cs; sincos(li * st, &sn, &cs);
        const double mag = exp(lr * st), br = mag * cs - 1.0, bi = mag * sn;
        const double den = lr * lr + li * li;
        const double fr = (br * lr + bi * li) / den, fi = (bi * lr - br * li) / den;
        const double xr = b_re[(size_t)pi * SC + c], xi = b_im[(size_t)pi * SC + c];
        BB[e] = (f32x2){(float)(fr * xr - fi * xi), (float)(fr * xi + fi * xr)};
    }
    { const int dir = F.tid >> 8, cq = (F.tid >> 6) & 3, p = F.tid & 63;
      const size_t ci = ((size_t)((l * 2 + dir) * SG + g) * SC + 4 * s + cq) * SP + p;
      CQ[F.tid] = (f32x2){c_re[ci], c_im[ci]}; }
    __syncthreads();
    for (int e = F.tid; e < 2 * 32 * 64; e += NTHREADS) {
        const int dir = e >> 11, tau = (e >> 6) & 31, cq = (e >> 4) & 3, c2 = e & 15;
        float acc = 0.f;
#pragma unroll 8
        for (int p = 0; p < SP; ++p) {
            const f32x2 cc = CQ[(dir * 4 + cq) * 64 + p], lp = LP[(dir * 33 + tau) * 64 + p], bb = BB[(dir * 64 + p) * 16 + c2];
            const float zr = cc.x * lp.x - cc.y * lp.y, zi = cc.x * lp.y + cc.y * lp.x;
            acc += zr * bb.x - zi * bb.y;
        }
        KT[e] = acc;
    }
    __syncthreads();
    bf16_t* M2 = (bf16_t*)(F.ws + WS_M2) + (size_t)(l * SG + g) * N2 * K2;
    { const int k = F.tid, j = k >> 4, c2 = k & 15;
      const float dk = d_skip[l * SW + g * SC + c2];
      for (int r = 0; r < 128; ++r) {
          const int i = r >> 2, cq = r & 3, c = 4 * s + cq;
          float v = 0.f;
          if (j <= i) v += KT[((0 * 32 + (i - j)) * 4 + cq) * 16 + c2];
          if (j >= i) v += KT[((1 * 32 + (j - i)) * 4 + cq) * 16 + c2];
          if (j == i && c == c2) v += dk;
          M2[(size_t)(i * SC + c) * K2 + k] = (bf16_t)f2bf(v);
      } }
    if (F.tid < 256) {
        const int kk = F.tid, dir = kk >> 7, im = (kk >> 6) & 1, p = kk & 63;
        for (int r = 0; r < 128; ++r) {
            const int i = r >> 2, cq = r & 3, c = 4 * s + cq;
            const f32x2 cc = CQ[(dir * 4 + cq) * 64 + p];
            const int tau = dir == 0 ? i + 1 : CL - i;
            const f32x2 lp = LP[(dir * 33 + tau) * 64 + p];
            const float v = im ? -(cc.x * lp.y + cc.y * lp.x) : (cc.x * lp.x - cc.y * lp.y);
            M2[(size_t)(i * SC + c) * K2 + K1 + kk] = (bf16_t)f2bf(v);
        }
    }
    bf16_t* W1 = (bf16_t*)(F.ws + WS_W1) + (size_t)(l * SG + g) * N1 * K1;
    { const int k = F.tid, j = k >> 4, c2 = k & 15;
      for (int rr = 0; rr < 64; ++rr) {
          const int n = 64 * s + rr, dir = n >> 7, im = (n >> 6) & 1, p = n & 63;
          const int tau = dir == 0 ? CL - 1 - j : j;
          const f32x2 lp = LP[(dir * 33 + tau) * 64 + p], bb = BB[(dir * 64 + p) * 16 + c2];
          const float v = im ? (lp.x * bb.y + lp.y * bb.x) : (lp.x * bb.x - lp.y * bb.y);
          W1[(size_t)n * K1 + k] = (bf16_t)f2bf(v);
      } }
    __syncthreads();
}

__device__ __forceinline__ float wave_max(float v);
__device__ __forceinline__ unsigned pk4_i8(float a, float b, float c, float d);
__device__ __forceinline__ void transpose_item_i8(const float* W, int K, int N, unsigned char* WT, const unsigned* cmaxbits, float* wsc, LAS float* scr, int item, int lane) {
    const int nblk = N / 32, kb = item / nblk, nb = item % nblk, k0 = 64 * kb, n0 = 32 * nb;
#pragma unroll 8
    for (int i = 0; i < 32; ++i) { const int kk = 2 * i + (lane >> 5); scr[kk * 33 + (lane & 31)] = W[(size_t)(k0 + kk) * N + n0 + (lane & 31)]; }
    asm volatile("s_waitcnt lgkmcnt(0)" ::: "memory");
    const int c = lane & 3;
#pragma unroll
    for (int j = 0; j < 2; ++j) { const int n = (lane >> 2) + 16 * j; const LAS float* s = scr + (16 * c) * 33 + n;
        const float mx = __builtin_bit_cast(float, cmaxbits[n0 + n]);
        const float sc = mx > 0.f ? mx * (1.f / 127.f) : 1.f, is = 1.f / sc;
        u32x4 o; o.x = pk4_i8(s[0 * 33] * is, s[1 * 33] * is, s[2 * 33] * is, s[3 * 33] * is); o.y = pk4_i8(s[4 * 33] * is, s[5 * 33] * is, s[6 * 33] * is, s[7 * 33] * is);
        o.z = pk4_i8(s[8 * 33] * is, s[9 * 33] * is, s[10 * 33] * is, s[11 * 33] * is); o.w = pk4_i8(s[12 * 33] * is, s[13 * 33] * is, s[14 * 33] * is, s[15 * 33] * is);
        *(u32x4*)(WT + (size_t)(n0 + n) * K + k0 + 16 * c) = o;
        if (kb == 0 && c == 0) wsc[n0 + n] = sc; }
    asm volatile("s_waitcnt lgkmcnt(0)" ::: "memory");
}
__device__ __forceinline__ const float* i8w_src(const Args& a, int mi, int& N, int& coff) {
    if (mi < 2) { N = 2048; coff = WSC_IN + mi * 2048; return a.in[1] + (size_t)mi * DM * 2048; }
    if (mi < 4) { N = DM; coff = WSC_OUT + (mi - 2) * DM; return a.in[2] + (size_t)(mi - 2) * DM * DM; }
    N = DM; coff = WSC_Q + (mi - 4) * DM; return a.in[17] + (size_t)(mi - 4) * DM * DM;
}
template <int NR>
__device__ __forceinline__ void rms_rows_to_i8(const float* xrow, const float* g, unsigned char* qrow, float* qscale, bf16_t* xcopy, int lane) {
    f32x4 v[NR][4];
#pragma unroll
    for (int r = 0; r < NR; ++r)
#pragma unroll
        for (int j = 0; j < 4; ++j) v[r][j] = *((const f32x4*)(xrow + (size_t)r * DM) + lane + 64 * j);
    f32x4 gg[4];
#pragma unroll
    for (int j = 0; j < 4; ++j) gg[j] = *((const f32x4*)g + lane + 64 * j);
#pragma unroll
    for (int r = 0; r < NR; ++r) {
        float s = 0.f;
#pragma unroll
        for (int j = 0; j < 4; ++j) s += (v[r][j].x * v[r][j].x + v[r][j].y * v[r][j].y) + (v[r][j].z * v[r][j].z + v[r][j].w * v[r][j].w);
        if (xcopy) {
#pragma unroll
            for (int j = 0; j < 4; ++j) { u32x2 w; w.x = pk2(v[r][j].x, v[r][j].y); w.y = pk2(v[r][j].z, v[r][j].w); *((u32x2*)(xcopy + (size_t)r * DM) + lane + 64 * j) = w; }
        }
        const float inv = rsqrtf(wave_sum(s) * (1.f / DM) + EPS);
        float mx = 0.f;
#pragma unroll
        for (int j = 0; j < 4; ++j) { v[r][j] = (f32x4){v[r][j].x * inv * gg[j].x, v[r][j].y * inv * gg[j].y, v[r][j].z * inv * gg[j].z, v[r][j].w * inv * gg[j].w};
            mx = fmaxf(mx, fmaxf(fmaxf(fabsf(v[r][j].x), fabsf(v[r][j].y)), fmaxf(fabsf(v[r][j].z), fabsf(v[r][j].w)))); }
        mx = wave_max(mx);
        const float sc = mx > 0.f ? mx * (1.f / 127.f) : 1.f, is = 1.f / sc;
        unsigned* q4 = (unsigned*)(qrow + (size_t)r * DM) + lane;
#pragma unroll
        for (int j = 0; j < 4; ++j) q4[64 * j] = pk4_i8(v[r][j].x * is, v[r][j].y * is, v[r][j].z * is, v[r][j].w * is);
        if (lane == 0) qscale[r] = sc;
    }
}
template <int NR, bool NT>
__device__ __forceinline__ void load_xb_rows(float (&v)[NR][16], const bf16_t* xrow, int lane) {
    u32x4 w[NR][2];
#pragma unroll
    for (int r = 0; r < NR; ++r)
#pragma unroll
        for (int q = 0; q < 2; ++q) { const u32x4* p = (const u32x4*)(xrow + (size_t)r * DM + 512 * q + 8 * lane); w[r][q] = NT ? __builtin_nontemporal_load(p) : *p; }
#pragma unroll
    for (int r = 0; r < NR; ++r)
#pragma unroll
        for (int q = 0; q < 2; ++q)
#pragma unroll
            for (int k = 0; k < 4; ++k) { v[r][8 * q + 2 * k] = bflo(w[r][q][k]); v[r][8 * q + 2 * k + 1] = bfhi(w[r][q][k]); }
}
__device__ __forceinline__ void rms_inplace16(float (&v)[16], const float* g, int lane) {
    float s = 0.f;
#pragma unroll
    for (int k = 0; k < 16; ++k) s += v[k] * v[k];
    const float inv = rsqrtf(wave_sum(s) * (1.f / DM) + EPS);
#pragma unroll
    for (int q = 0; q < 2; ++q) { const f32x4 g0 = *(const f32x4*)(g + 512 * q + 8 * lane), g1 = *(const f32x4*)(g + 512 * q + 8 * lane + 4);
#pragma unroll
        for (int k = 0; k < 4; ++k) { v[8 * q + k] *= inv * g0[k]; v[8 * q + 4 + k] *= inv * g1[k]; } }
}
__device__ __forceinline__ void store_i8_row16(const float (&v)[16], unsigned char* qrow, float* qscale, int lane) {
    float mx = 0.f;
#pragma unroll
    for (int k = 0; k < 16; ++k) mx = fmaxf(mx, fabsf(v[k]));
    mx = wave_max(mx);
    const float sc = mx > 0.f ? mx * (1.f / 127.f) : 1.f, is = 1.f / sc;
#pragma unroll
    for (int q = 0; q < 2; ++q) { u32x2 w; w.x = pk4_i8(v[8 * q] * is, v[8 * q + 1] * is, v[8 * q + 2] * is, v[8 * q + 3] * is); w.y = pk4_i8(v[8 * q + 4] * is, v[8 * q + 5] * is, v[8 * q + 6] * is, v[8 * q + 7] * is);
        *(u32x2*)(qrow + 512 * q + 8 * lane) = w; }
    if (lane == 0) *qscale = sc;
}
template <int NR>
__device__ __forceinline__ void rms_xb_rows_to_i8(const bf16_t* xrow, const float* g, unsigned char* qrow, float* qscale, int lane) {
    float v[NR][16];
    load_xb_rows<NR, false>(v, xrow, lane);
#pragma unroll
    for (int r = 0; r < NR; ++r) { rms_inplace16(v[r], g, lane); store_i8_row16(v[r], qrow + (size_t)r * DM, qscale + r, lane); }
}
__device__ __forceinline__ void convert_experts(const Ctx& F, const Args& a, int l);
__device__ __forceinline__ void p0a_stream(const Ctx& F, const Args& a) {
    const int gw = F.bid * NWAVES + F.wave, NGW = F.G * NWAVES;
    { unsigned* wmax = (unsigned*)(F.ws + WS_WMAX);
      for (int t = gw; t < 128 * 16; t += NGW) {
          const int cg = t >> 4, seg = t & 15; int mi, cbase;
          if (cg < 64) { mi = cg >> 5; cbase = (cg & 31) * 64; } else if (cg < 96) { mi = 2 + ((cg - 64) >> 4); cbase = ((cg - 64) & 15) * 64; } else { mi = 4 + ((cg - 96) >> 4); cbase = ((cg - 96) & 15) * 64; }
          int N, coff; const float* W = i8w_src(a, mi, N, coff);
          float mx = 0.f;
#pragma unroll 16
          for (int k = 0; k < 64; ++k) mx = fmaxf(mx, fabsf(W[(size_t)(seg * 64 + k) * N + cbase + F.lane]));
          atomicMax(&wmax[coff + cbase + F.lane], __builtin_bit_cast(unsigned, mx));
      } }
    LAS float* scr = (LAS float*)(F.lds + F.wave * 16384);
    constexpr int I_GLU = (SW / 64) * (1024 / 32);
    for (int it = gw; it < NLAYER * I_GLU; it += NGW) { const int l = it / I_GLU, r = it % I_GLU;
        transpose_item(a.in[16] + (size_t)l * SW * 1024, SW, 1024, (bf16_t*)(F.ws + WS_WGLU) + (size_t)l * 1024 * SW, RowGlu(), scr, r, F.lane); }
    { const float* sk = a.in[18]; bf16_t* o = (bf16_t*)(F.ws + WS_SK); const int n4 = NLAYER * 2 * PH * PKEYS * 64 / 4;
      for (int i = gw * 64 + F.lane; i < n4; i += NGW * 64) { const f32x4 v = ((const f32x4*)sk)[i]; u32x2 w; w.x = pk2(v.x, v.y); w.y = pk2(v.z, v.w); ((u32x2*)o)[i] = w; } }
    for (int m = gw * 4; m < TOK; m += NGW * 4) rms_rows_to_i8<4>(a.in[0] + (size_t)m * DM, a.in[6], F.ws + WS_H + (size_t)m * DM, (float*)(F.ws + WS_HSC) + m, (bf16_t*)(F.ws + WS_XB) + (size_t)m * DM, F.lane);
    convert_experts(F, a, 0);
}
__device__ __forceinline__ void p0a_prologue(const Ctx& F, const Args& a) {
    if ((F.bid & 1) == 0) {
        for (int u = F.bid; u < NLAYER * SG * 4; u += F.G) ssm_build_unit(F, a, u >> 7, (u >> 2) & 31, u & 3);
        __syncthreads();
        p0a_stream(F, a);
    } else {
        p0a_stream(F, a);
        __syncthreads();
        for (int u = F.bid; u < NLAYER * SG * 4; u += F.G) ssm_build_unit(F, a, u >> 7, (u >> 2) & 31, u & 3);
    }
}
__device__ __forceinline__ void p0b_prologue(const Ctx& F, const Args& a) {
    LAS float* scr = (LAS float*)(F.lds + F.wave * 16384);
    const int gw = F.bid * NWAVES + F.wave, NGW = F.G * NWAVES;
    const unsigned* wmax = (const unsigned*)(F.ws + WS_WMAX); float* wsc = (float*)(F.ws + WS_WSC);
    constexpr int I_IN = (DM / 64) * (2048 / 32), I_SQ = (DM / 64) * (DM / 32), I_ALL = 2 * I_IN + 4 * I_SQ;
    for (int it = gw; it < I_ALL; it += NGW) {
        int mi, r;
        if (it < 2 * I_IN) { mi = it / I_IN; r = it % I_IN; } else { mi = 2 + (it - 2 * I_IN) / I_SQ; r = (it - 2 * I_IN) % I_SQ; }
        int N, coff; const float* W = i8w_src(a, mi, N, coff);
        unsigned char* dst = mi < 2 ? F.ws + WS_WIN + (size_t)mi * 2048 * DM : mi < 4 ? F.ws + WS_WOUT + (size_t)(mi - 2) * DM * DM : F.ws + WS_WQ + (size_t)(mi - 4) * DM * DM;
        transpose_item_i8(W, DM, N, dst, wmax + coff, wsc + coff, scr, r, F.lane);
    }
}

#define GCH 128
constexpr int GNCH = DM / GCH;
__device__ __forceinline__ float wave_max(float v) {
    v = fmaxf(v, dppf<0xB1>(v)); v = fmaxf(v, dppf<0x4E>(v)); v = fmaxf(v, dppf<0x141>(v)); v = fmaxf(v, dppf<0x140>(v));
    v = fmaxf(v, __shfl_xor(v, 16)); v = fmaxf(v, __shfl_xor(v, 32));
    return v;
}
__device__ __forceinline__ unsigned pk4_i8(float a, float b, float c, float d) {
    const int ia = (int)rintf(a), ib = (int)rintf(b), ic = (int)rintf(c), id = (int)rintf(d);
    return (unsigned)(ia & 255) | ((unsigned)(ib & 255) << 8) | ((unsigned)(ic & 255) << 16) | ((unsigned)id << 24);
}
template <int NR>
__device__ __forceinline__ void convert_rows_i8(const float* stab, unsigned char* dtab, float* dscale, int e0, int estep, int lane) {
    f32x4 v[NR][4];
#pragma unroll
    for (int r = 0; r < NR; ++r)
#pragma unroll
        for (int j = 0; j < 4; ++j) v[r][j] = *(const f32x4*)(stab + (size_t)(e0 + r * estep) * DM + 16 * lane + 4 * j);
#pragma unroll
    for (int r = 0; r < NR; ++r) {
        const int e = e0 + r * estep;
        float mx = 0.f;
#pragma unroll
        for (int j = 0; j < 4; ++j) mx = fmaxf(mx, fmaxf(fmaxf(fabsf(v[r][j].x), fabsf(v[r][j].y)), fmaxf(fabsf(v[r][j].z), fabsf(v[r][j].w))));
        mx = wave_max(mx);
        const float sc = mx > 0.f ? mx * (1.f / 127.f) : 1.f, is = 1.f / sc;
        u32x4 w;
        w.x = pk4_i8(v[r][0].x * is, v[r][0].y * is, v[r][0].z * is, v[r][0].w * is); w.y = pk4_i8(v[r][1].x * is, v[r][1].y * is, v[r][1].z * is, v[r][1].w * is);
        w.z = pk4_i8(v[r][2].x * is, v[r][2].y * is, v[r][2].z * is, v[r][2].w * is); w.w = pk4_i8(v[r][3].x * is, v[r][3].y * is, v[r][3].z * is, v[r][3].w * is);
        const int d0 = 16 * lane, c = d0 / GCH, off = d0 % GCH;
        *(u32x4*)(dtab + ((size_t)c * NEXP + e) * GCH + off) = w;
        if (lane == 0) dscale[e] = sc;
    }
}
__device__ __forceinline__ void convert_experts(const Ctx& F, const Args& a, int l) {
    const float* su = a.in[19] + (size_t)l * NEXP * DM; const float* sv = a.in[20] + (size_t)l * NEXP * DM;
    unsigned char* du = F.ws + WS_EU; unsigned char* dv = F.ws + WS_EV;
    float* scu = (float*)(F.ws + WS_ESC); float* scv = scu + NEXP;
    const int NGW = F.G * NWAVES;
    for (int e = F.bid * NWAVES + F.wave; e < NEXP; e += 4 * NGW) {
        if (e + 3 * NGW < NEXP) { convert_rows_i8<4>(su, du, scu, e, NGW, F.lane); convert_rows_i8<4>(sv, dv, scv, e, NGW, F.lane); }
        else for (int r = 0; r < 4; ++r) if (e + r * NGW < NEXP) { convert_rows_i8<1>(su, du, scu, e + r * NGW, NGW, F.lane); convert_rows_i8<1>(sv, dv, scv, e + r * NGW, NGW, F.lane); }
    }
}
constexpr int ATT_KT = 0, ATT_VT = 49152, ATT_TAB = 98304, ATT_TABW = 200, ATT_OST = 117504, ATT_OROW = 144;
static_assert(ATT_OST + 8 * 32 * ATT_OROW <= MISC_OFF, "attention LDS map");
__device__ __forceinline__ int crow(int r, int hi) { return (r & 3) + 8 * (r >> 2) + 4 * hi; }
struct AttnUnit { int p, b, h, r, jblk, dsh, Lsub; };
__device__ __forceinline__ AttnUnit attn_decode(int u) {
    AttnUnit U; U.p = u >> 10; const int v = u & 1023, bh = v >> 4, rb = v & 15; U.b = bh >> 3; U.h = bh & 7;
    U.dsh = 2 * U.p; U.Lsub = SEQ >> U.dsh; const int nblk = 16 >> U.dsh; U.r = rb / nblk; U.jblk = (rb % nblk) * 256; return U;
}
template <bool ISV> __device__ __forceinline__ void attn_stage_dma(LAS unsigned char* lds, const bf16_t* src, const AttnUnit& U, int tid, int wave) {
#pragma unroll
    for (int n = 0; n < 6; ++n) {
        const int c = tid + NTHREADS * n, row = c >> 3, pch = c & 7, kp = U.jblk - 64 + row;
        const int ch = ISV ? (pch ^ (((row >> 1) & 1) << 2)) : (pch ^ ((row >> 1) & 7));
        const bool ok = (unsigned)kp < (unsigned)U.Lsub;
        const size_t off = ((size_t)U.b * SEQ + ((size_t)(ok ? kp : 0) << U.dsh) + U.r) * AW + U.h * HD + ch * 8;
        __builtin_amdgcn_global_load_lds((const unsigned*)(src + off), (LAS unsigned*)(lds + (ISV ? ATT_VT : ATT_KT) + (wave * 64 + NTHREADS * n) * 16), 16, 0, 0);
    }
}
template <bool MASK> __device__ __forceinline__ float attn_logits(f32x16 (&acc)[5], const LAS float* tb, int kp0, int Lsub) {
    const float C2 = 0.125f * LOG2E;
    float mx = -3e38f;
#pragma unroll
    for (int kt = 0; kt < 5; ++kt) {
#pragma unroll
        for (int i = 0; i < 16; ++i) {
            const int kr = 32 * kt + (i & 3) + 8 * (i >> 2);
            float x = acc[kt][i] * C2 + tb[kr];
            if (MASK) x = ((unsigned)(kp0 + kr) < (unsigned)Lsub) ? x : -1e30f;
            acc[kt][i] = x; mx = fmaxf(mx, x);
        }
        __builtin_amdgcn_sched_barrier(0);
    }
    return mx;
}
__device__ __forceinline__ void attn_phase(const Ctx& F, const Args& a, int u0, int u1, int ustep) {
    const bf16_t* Q = (const bf16_t*)(F.ws + WS_Q); const bf16_t* Kb = (const bf16_t*)(F.ws + WS_K); const bf16_t* Vb = (const bf16_t*)(F.ws + WS_V);
    bf16_t* OP = (bf16_t*)(F.ws + WS_OP); float* LSE = (float*)(F.ws + WS_LSE);
    LAS unsigned char* lds = F.lds;
    LAS float* tab = (LAS float*)(lds + ATT_TAB);
    const float* rel_bias = a.in[3];
    __syncthreads();
    for (int e = F.tid; e < 3 * NH * ATT_TABW; e += NTHREADS) {
        const int p = e / (NH * ATT_TABW), h = (e / ATT_TABW) % NH, i = e % ATT_TABW, dl = i - 96;
        float v = -1e30f;
        if (dl >= -64 && dl <= 64) v = rel_bias[(int)a.bkt[p][dl + 64] * NH + h] * LOG2E;
        tab[e] = v;
    }
    const int lane = F.lane, w = F.wave, ql = lane & 31, hh = lane >> 5;
    const int tq = (lane & 15) >> 2, tp = lane & 3, tblk = (lane >> 4) & 1;
    if (u0 >= u1) { __syncthreads(); return; }
    AttnUnit U = attn_decode(u0);
    attn_stage_dma<false>(lds, Kb, U, F.tid, w);
    bf16x8 qf[4];
    { const size_t tq0 = (size_t)U.b * SEQ + ((size_t)(U.jblk + 32 * w + ql) << U.dsh) + U.r;
#pragma unroll
      for (int ks = 0; ks < 4; ++ks) qf[ks] = *(const bf16x8*)(Q + tq0 * AW + U.h * HD + 16 * ks + 8 * hh); }
    for (int u = u0; u < u1; u += ustep) {
        const bool has_next = (u + ustep) < u1;
        const AttnUnit N = attn_decode(has_next ? u + ustep : u);
        const int d = 1 << U.dsh;
        const int jq = U.jblk + 32 * w + ql;
        const size_t tokq = (size_t)U.b * SEQ + (size_t)jq * d + U.r;
        asm volatile("s_waitcnt vmcnt(0)" ::: "memory");
        __syncthreads();
        attn_stage_dma<true>(lds, Vb, U, F.tid, w);
        f32x16 acc[5];
#pragma unroll
        for (int kt = 0; kt < 5; ++kt) {
            const int rowk = 32 * w + 32 * kt + ql;
            bf16x8 kf[4];
#pragma unroll
            for (int ks = 0; ks < 4; ++ks) kf[ks] = *(const LAS bf16x8*)(lds + ATT_KT + rowk * 128 + (((2 * ks + hh) ^ ((rowk >> 1) & 7)) << 4));
#pragma unroll
            for (int i = 0; i < 16; ++i) acc[kt][i] = 0.f;
#pragma unroll
            for (int ks = 0; ks < 4; ++ks) acc[kt] = __builtin_amdgcn_mfma_f32_32x32x16_bf16(kf[ks], qf[ks], acc[kt], 0, 0, 0);
        }
        if (has_next) { const size_t tqn = (size_t)N.b * SEQ + ((size_t)(N.jblk + 32 * w + ql) << N.dsh) + N.r;
#pragma unroll
            for (int ks = 0; ks < 4; ++ks) qf[ks] = *(const bf16x8*)(Q + tqn * AW + N.h * HD + 16 * ks + 8 * hh); }
        const LAS float* tb = tab + (U.p * NH + U.h) * ATT_TABW + (32 - ql + 4 * hh);
        const int kp0 = U.jblk + 32 * w - 64 + 4 * hh;
        const bool edge = (U.jblk + 32 * w - 64 < 0) || (U.jblk + 32 * w + 96 > U.Lsub);
        float mx = edge ? attn_logits<true>(acc, tb, kp0, U.Lsub) : attn_logits<false>(acc, tb, kp0, U.Lsub);
        mx = fmaxf(mx, __shfl_xor(mx, 32));
        float sum = 0.f;
        bf16x8 pf[5][2];
#pragma unroll
        for (int kt = 0; kt < 5; ++kt) {
#pragma unroll
            for (int i = 0; i < 16; ++i) { const float e = __builtin_amdgcn_exp2f(acc[kt][i] - mx); acc[kt][i] = e; sum += e; }
#pragma unroll
            for (int s = 0; s < 2; ++s) {
                u32x4 wv; wv.x = pk2(acc[kt][8 * s + 0], acc[kt][8 * s + 1]); wv.y = pk2(acc[kt][8 * s + 2], acc[kt][8 * s + 3]);
                wv.z = pk2(acc[kt][8 * s + 4], acc[kt][8 * s + 5]); wv.w = pk2(acc[kt][8 * s + 6], acc[kt][8 * s + 7]);
                pf[kt][s] = __builtin_bit_cast(bf16x8, wv);
            }
        }
        sum += __shfl_xor(sum, 32);
        asm volatile("s_waitcnt vmcnt(0)" ::: "memory");
        __syncthreads();
        if (has_next) attn_stage_dma<false>(lds, Kb, N, F.tid, w);
        f32x16 o[2];
#pragma unroll
        for (int dt = 0; dt < 2; ++dt)
#pragma unroll
            for (int i = 0; i < 16; ++i) o[dt][i] = 0.f;
        const int sw = (tq >> 1) & 1;
        const int vrow0 = 32 * w + 4 * hh + tq;
        const unsigned vb0 = ATT_VT + vrow0 * 128 + ((((0 ^ sw) << 2) + 2 * tblk + (tp >> 1)) << 4) + 8 * (tp & 1);
        const unsigned vb1 = ATT_VT + vrow0 * 128 + ((((1 ^ sw) << 2) + 2 * tblk + (tp >> 1)) << 4) + 8 * (tp & 1);
        {
            s16x4 tr[2][4];
#define ATT_TRLOAD(buf, st) do { const int _ro = (16 * (st)) * 128; \
                tr[buf][0] = __builtin_amdgcn_ds_read_tr16_b64_v4i16((LAS s16x4*)(lds + vb0 + _ro)); tr[buf][1] = __builtin_amdgcn_ds_read_tr16_b64_v4i16((LAS s16x4*)(lds + vb0 + _ro + 8 * 128)); \
                tr[buf][2] = __builtin_amdgcn_ds_read_tr16_b64_v4i16((LAS s16x4*)(lds + vb1 + _ro)); tr[buf][3] = __builtin_amdgcn_ds_read_tr16_b64_v4i16((LAS s16x4*)(lds + vb1 + _ro + 8 * 128)); } while (0)
            ATT_TRLOAD(0, 0);
#pragma unroll
            for (int st = 0; st < 10; ++st) {
                if (st + 1 < 10) ATT_TRLOAD((st + 1) & 1, st + 1);
                const s16x4 l0 = tr[st & 1][0], h0 = tr[st & 1][1], l1 = tr[st & 1][2], h1 = tr[st & 1][3];
                const bf16x8 a0 = (bf16x8){l0[0], l0[1], l0[2], l0[3], h0[0], h0[1], h0[2], h0[3]};
                const bf16x8 a1 = (bf16x8){l1[0], l1[1], l1[2], l1[3], h1[0], h1[1], h1[2], h1[3]};
                o[0] = __builtin_amdgcn_mfma_f32_32x32x16_bf16(a0, pf[st >> 1][st & 1], o[0], 0, 0, 0);
                o[1] = __builtin_amdgcn_mfma_f32_32x32x16_bf16(a1, pf[st >> 1][st & 1], o[1], 0, 0, 0);
            }
#undef ATT_TRLOAD
        }
        const float inv = 1.f / sum;
        {
            LAS unsigned char* ost = lds + ATT_OST + w * (32 * ATT_OROW);
#pragma unroll
            for (int dt = 0; dt < 2; ++dt)
#pragma unroll
                for (int rq = 0; rq < 4; ++rq) {
                    u32x2 wv; wv.x = pk2(o[dt][4 * rq + 0] * inv, o[dt][4 * rq + 1] * inv); wv.y = pk2(o[dt][4 * rq + 2] * inv, o[dt][4 * rq + 3] * inv);
                    *(LAS u32x2*)(ost + ql * ATT_OROW + (32 * dt + 8 * rq + 4 * hh) * 2) = wv;
                }
            asm volatile("s_waitcnt lgkmcnt(0)" ::: "memory");
            const int orq = lane >> 3, oc = lane & 7;
#pragma unroll
            for (int rr = 0; rr < 4; ++rr) {
                const int row = 8 * rr + orq;
                const u32x4 v = *(const LAS u32x4*)(ost + row * ATT_OROW + 16 * oc);
                const size_t tokr = (size_t)U.b * SEQ + (size_t)(U.jblk + 32 * w + row) * d + U.r;
                *(u32x4*)(OP + ((size_t)U.p * TOK + tokr) * AW + U.h * HD + 8 * oc) = v;
            }
        }
        if (hh == 0) LSE[((size_t)U.p * TOK + tokq) * NH + U.h] = (mx + __builtin_amdgcn_logf(sum)) * LN2;
        U = N;
    }
    __syncthreads();
}

__device__ __forceinline__ void carry_unit(const Ctx& F, const Args& a, int l, int g, int pml) {
    const float* E = (const float*)(F.ws + WS_E); bf16_t* UX = (bf16_t*)(F.ws + WS_UX);
    const f32x2* LAML = (const f32x2*)(F.ws + WS_LAML);
    if (F.tid < 256) {
        const int p = F.tid & 63, dir = (F.tid >> 6) & 1, b = 2 * pml + (F.tid >> 7);
        const f32x2 lm = LAML[((l * 2 + dir) * SG + g) * SP + p];
        float sr = 0.f, si = 0.f;
        const size_t rbase = (size_t)g * ROWS_G + (size_t)b * NCHUNK;
        for (int cb = 0; cb < NCHUNK; cb += 32) {
            float er[32], ei[32];
#pragma unroll
            for (int j = 0; j < 32; ++j) { const int c = dir ? NCHUNK - 1 - (cb + j) : cb + j; const float* ep = E + (rbase + c) * N1 + dir * 128 + p; er[j] = ep[0]; ei[j] = ep[64]; }
#pragma unroll
            for (int j = 0; j < 32; ++j) {
                const int c = dir ? NCHUNK - 1 - (cb + j) : cb + j;
                bf16_t* up = UX + (rbase + c) * K2 + K1 + dir * 128 + p;
                up[0] = (bf16_t)f2bf(sr); up[64] = (bf16_t)f2bf(si);
                const float nr = er[j] + lm.x * sr - lm.y * si, ni = ei[j] + lm.x * si + lm.y * sr;
                sr = nr; si = ni;
            }
        }
    }
}

__device__ __forceinline__ void mixprep_phase(const Ctx& F, const Args& a, int l) {
    const bf16_t* OP = (const bf16_t*)(F.ws + WS_OP); const float* LSE = (const float*)(F.ws + WS_LSE); const bf16_t* SS = (const bf16_t*)(F.ws + WS_SSM);
    unsigned char* H = F.ws + WS_H; float* HS = (float*)(F.ws + WS_HSC);
    const float* ga = a.in[4] + l * AW; const float* gs = a.in[5] + l * SW;
    const int lane = F.lane, hd = lane >> 3;
    constexpr int NT = 4;
    const f32x4 g0 = *(const f32x4*)(ga + lane * 8), g1 = *(const f32x4*)(ga + lane * 8 + 4), h0 = *(const f32x4*)(gs + lane * 8), h1 = *(const f32x4*)(gs + lane * 8 + 4);
    for (int tb = (F.bid * NWAVES + F.wave) * NT; tb < TOK; tb += F.G * NWAVES * NT) {
        u32x4 o[NT][3]; float ls[NT][3]; u32x4 sv[NT];
#pragma unroll
        for (int r = 0; r < NT; ++r) {
            const int t = tb + r;
#pragma unroll
            for (int p = 0; p < 3; ++p) { o[r][p] = *(const u32x4*)(OP + ((size_t)p * TOK + t) * AW + lane * 8); ls[r][p] = LSE[((size_t)p * TOK + t) * NH + hd]; }
            sv[r] = *(const u32x4*)(SS + (size_t)t * SW + lane * 8);
        }
#pragma unroll
        for (int r = 0; r < NT; ++r) {
            const int t = tb + r;
            const float mx = fmaxf(ls[r][0], fmaxf(ls[r][1], ls[r][2]));
            float w0 = __expf(ls[r][0] - mx), w1 = __expf(ls[r][1] - mx), w2 = __expf(ls[r][2] - mx);
            const float wi = 1.f / (w0 + w1 + w2); w0 *= wi; w1 *= wi; w2 *= wi;
            float av[8], sq = 0.f;
#pragma unroll
            for (int j = 0; j < 4; ++j) {
                av[2 * j] = w0 * bflo(o[r][0][j]) + w1 * bflo(o[r][1][j]) + w2 * bflo(o[r][2][j]);
                av[2 * j + 1] = w0 * bfhi(o[r][0][j]) + w1 * bfhi(o[r][1][j]) + w2 * bfhi(o[r][2][j]);
                sq += av[2 * j] * av[2 * j] + av[2 * j + 1] * av[2 * j + 1];
            }
            float sv8[8], sq2 = 0.f;
#pragma unroll
            for (int j = 0; j < 4; ++j) { sv8[2 * j] = bflo(sv[r][j]); sv8[2 * j + 1] = bfhi(sv[r][j]); sq2 += sv8[2 * j] * sv8[2 * j] + sv8[2 * j + 1] * sv8[2 * j + 1]; }
            const float ia = rsqrtf(wave_sum(sq) * (1.f / AW) + EPS), is = rsqrtf(wave_sum(sq2) * (1.f / SW) + EPS);
            float qmx = 0.f;
#pragma unroll
            for (int j = 0; j < 4; ++j) { av[j] *= ia * g0[j]; av[4 + j] *= ia * g1[j]; sv8[j] *= is * h0[j]; sv8[4 + j] *= is * h1[j]; }
#pragma unroll
            for (int j = 0; j < 8; ++j) qmx = fmaxf(qmx, fmaxf(fabsf(av[j]), fabsf(sv8[j])));
            qmx = wave_max(qmx);
            const float sc = qmx > 0.f ? qmx * (1.f / 127.f) : 1.f, qs = 1.f / sc;
            u32x2 wa; wa.x = pk4_i8(av[0] * qs, av[1] * qs, av[2] * qs, av[3] * qs); wa.y = pk4_i8(av[4] * qs, av[5] * qs, av[6] * qs, av[7] * qs);
            u32x2 wb; wb.x = pk4_i8(sv8[0] * qs, sv8[1] * qs, sv8[2] * qs, sv8[3] * qs); wb.y = pk4_i8(sv8[4] * qs, sv8[5] * qs, sv8[6] * qs, sv8[7] * qs);
            *(u32x2*)(H + (size_t)t * DM + lane * 8) = wa;
            *(u32x2*)(H + (size_t)t * DM + AW + lane * 8) = wb;
            if (lane == 0) HS[t] = sc;
        }
    }
}

__device__ __forceinline__ unsigned ord_f(float f) { const int u = __builtin_bit_cast(int, f); return (unsigned)u ^ ((unsigned)(u >> 31) | 0x80000000u); }
__device__ __forceinline__ float unord_f(unsigned k) { return __builtin_bit_cast(float, (k & 0x80000000u) ? (k ^ 0x80000000u) : ~k); }
#define CE_D(x, y) { const unsigned _a = (x), _b = (y); (x) = _a > _b ? _a : _b; (y) = _a > _b ? _b : _a; }
#define CE_A(x, y) { const unsigned _a = (x), _b = (y); (x) = _a > _b ? _b : _a; (y) = _a > _b ? _a : _b; }
template <int B0> __device__ __forceinline__ void sort16_desc(unsigned (&v)[64]) {
    CE_D(v[B0 + 0], v[B0 + 13]); CE_D(v[B0 + 1], v[B0 + 12]); CE_D(v[B0 + 2], v[B0 + 15]); CE_D(v[B0 + 3], v[B0 + 14]); CE_D(v[B0 + 4], v[B0 + 8]); CE_D(v[B0 + 5], v[B0 + 6]); CE_D(v[B0 + 7], v[B0 + 11]); CE_D(v[B0 + 9], v[B0 + 10]);
    CE_D(v[B0 + 0], v[B0 + 5]); CE_D(v[B0 + 1], v[B0 + 7]); CE_D(v[B0 + 2], v[B0 + 9]); CE_D(v[B0 + 3], v[B0 + 4]); CE_D(v[B0 + 6], v[B0 + 13]); CE_D(v[B0 + 8], v[B0 + 14]); CE_D(v[B0 + 10], v[B0 + 15]); CE_D(v[B0 + 11], v[B0 + 12]);
    CE_D(v[B0 + 0], v[B0 + 1]); CE_D(v[B0 + 2], v[B0 + 3]); CE_D(v[B0 + 4], v[B0 + 5]); CE_D(v[B0 + 6], v[B0 + 8]); CE_D(v[B0 + 7], v[B0 + 9]); CE_D(v[B0 + 10], v[B0 + 11]); CE_D(v[B0 + 12], v[B0 + 13]); CE_D(v[B0 + 14], v[B0 + 15]);
    CE_D(v[B0 + 0], v[B0 + 2]); CE_D(v[B0 + 1], v[B0 + 3]); CE_D(v[B0 + 4], v[B0 + 10]); CE_D(v[B0 + 5], v[B0 + 11]); CE_D(v[B0 + 6], v[B0 + 7]); CE_D(v[B0 + 8], v[B0 + 9]); CE_D(v[B0 + 12], v[B0 + 14]); CE_D(v[B0 + 13], v[B0 + 15]);
    CE_D(v[B0 + 1], v[B0 + 2]); CE_D(v[B0 + 3], v[B0 + 12]); CE_D(v[B0 + 4], v[B0 + 6]); CE_D(v[B0 + 5], v[B0 + 7]); CE_D(v[B0 + 8], v[B0 + 10]); CE_D(v[B0 + 9], v[B0 + 11]); CE_D(v[B0 + 13], v[B0 + 14]);
    CE_D(v[B0 + 1], v[B0 + 4]); CE_D(v[B0 + 2], v[B0 + 6]); CE_D(v[B0 + 5], v[B0 + 8]); CE_D(v[B0 + 7], v[B0 + 10]); CE_D(v[B0 + 9], v[B0 + 13]); CE_D(v[B0 + 11], v[B0 + 14]);
    CE_D(v[B0 + 2], v[B0 + 4]); CE_D(v[B0 + 3], v[B0 + 6]); CE_D(v[B0 + 9], v[B0 + 12]); CE_D(v[B0 + 11], v[B0 + 13]);
    CE_D(v[B0 + 3], v[B0 + 5]); CE_D(v[B0 + 6], v[B0 + 8]); CE_D(v[B0 + 7], v[B0 + 9]); CE_D(v[B0 + 10], v[B0 + 12]);
    CE_D(v[B0 + 3], v[B0 + 4]); CE_D(v[B0 + 5], v[B0 + 6]); CE_D(v[B0 + 7], v[B0 + 8]); CE_D(v[B0 + 9], v[B0 + 10]); CE_D(v[B0 + 11], v[B0 + 12]);
    CE_D(v[B0 + 6], v[B0 + 7]); CE_D(v[B0 + 8], v[B0 + 9]);
}
template <int A0> __device__ __forceinline__ void bmerge16_desc(unsigned (&v)[64]) {
#pragma unroll
    for (int j = 8; j > 0; j >>= 1)
#pragma unroll
        for (int i = 0; i < 16; ++i) { const int l = i ^ j; if (l > i) { CE_D(v[A0 + i], v[A0 + l]); } }
}
template <int A0, int B0> __device__ __forceinline__ void merge_top16(unsigned (&v)[64]) {
#pragma unroll
    for (int i = 0; i < 16; ++i) { const unsigned x = v[A0 + i], y = v[B0 + 15 - i]; v[A0 + i] = x > y ? x : y; }
    bmerge16_desc<A0>(v);
}
__device__ __forceinline__ void top16_of_64(unsigned (&v)[64]) {
    sort16_desc<0>(v); sort16_desc<16>(v); sort16_desc<32>(v); sort16_desc<48>(v);
    merge_top16<0, 16>(v); merge_top16<32, 48>(v); merge_top16<0, 32>(v);
}
__device__ __forceinline__ void cross_half_top16(unsigned (&v)[64]) {
#pragma unroll
    for (int i = 0; i < 16; ++i) v[16 + i] = (unsigned)__shfl_xor((int)v[i], 32);
    merge_top16<0, 16>(v);
}

__device__ __forceinline__ void topk_block(const Ctx& F, const Args& a, int l, int tb) {
    const bf16_t* QB = (const bf16_t*)(F.ws + WS_QB); const bf16_t* SK = (const bf16_t*)(F.ws + WS_SK);
    int* EID = (int*)(F.ws + WS_EID); float* GATE = (float*)(F.ws + WS_GATE);
    const int lane = F.lane, tl = lane & 31, hh = lane >> 5;
    for (int r4 = 0; r4 < 4; ++r4) {
        const int tg = 4 * tb + r4, h = F.wave;
        const size_t tok = (size_t)tg * 32 + tl;
        unsigned t12[2][16];
#pragma unroll
        for (int part = 0; part < 2; ++part) {
            bf16x8 qf[4];
#pragma unroll
            for (int ks = 0; ks < 4; ++ks) qf[ks] = *(const bf16x8*)(QB + tok * DM + h * PQD + part * 64 + 16 * ks + 8 * hh);
            const bf16_t* skb = SK + (size_t)(((l * 2 + part) * PH + h) * PKEYS) * 64;
            unsigned v[64];
            bf16x8 kfr[4][4];
#pragma unroll
            for (int kt = 0; kt < 4; ++kt)
#pragma unroll
                for (int ks = 0; ks < 4; ++ks) kfr[kt][ks] = *(const bf16x8*)(skb + (size_t)(32 * kt + tl) * 64 + 16 * ks + 8 * hh);
#pragma unroll
            for (int kt = 0; kt < 4; ++kt)
#pragma unroll
                for (int ks = 0; ks < 4; ++ks) asm volatile("" : "+v"(kfr[kt][ks]));
#pragma unroll
            for (int kt = 0; kt < 4; ++kt) {
                f32x16 acc;
#pragma unroll
                for (int i = 0; i < 16; ++i) acc[i] = 0.f;
#pragma unroll
                for (int ks = 0; ks < 4; ++ks) acc = __builtin_amdgcn_mfma_f32_32x32x16_bf16(kfr[kt][ks], qf[ks], acc, 0, 0, 0);
#pragma unroll
                for (int i = 0; i < 16; ++i) { const int key = 32 * kt + (i & 3) + 8 * (i >> 2) + 4 * hh; v[16 * kt + i] = (ord_f(acc[i]) & ~127u) | (unsigned)(127 - key); }
            }
            top16_of_64(v);
            cross_half_top16(v);
#pragma unroll
            for (int i = 0; i < 16; ++i) t12[part][i] = v[i];
        }
        float f1[16], f2[16];
#pragma unroll
        for (int i = 0; i < 16; ++i) { f1[i] = unord_f(t12[0][i] & ~127u); f2[i] = unord_f(t12[1][i] & ~127u); }
        unsigned v[64];
        {
            int n = 0;
#pragma unroll
            for (int aa = 0; aa < 16; ++aa)
#pragma unroll
                for (int bb = 0; bb < 16; ++bb)
                    if ((aa + 1) * (bb + 1) <= 16) { v[n] = (ord_f(f1[aa] + f2[bb]) & ~255u) | (unsigned)(255 - (16 * aa + bb)); ++n; }
#pragma unroll
            for (int i = 50; i < 64; ++i) v[i] = 0u;
        }
        top16_of_64(v);
        unsigned i1p[4], i2p[4];
#pragma unroll
        for (int w4 = 0; w4 < 4; ++w4) {
            i1p[w4] = (127u - (t12[0][4 * w4] & 127u)) | ((127u - (t12[0][4 * w4 + 1] & 127u)) << 8) | ((127u - (t12[0][4 * w4 + 2] & 127u)) << 16) | ((127u - (t12[0][4 * w4 + 3] & 127u)) << 24);
            i2p[w4] = (127u - (t12[1][4 * w4] & 127u)) | ((127u - (t12[1][4 * w4 + 1] & 127u)) << 8) | ((127u - (t12[1][4 * w4 + 2] & 127u)) << 16) | ((127u - (t12[1][4 * w4 + 3] & 127u)) << 24);
        }
        float sc[16]; int ex[16];
        float den = 0.f; const float s0 = unord_f(v[0] & ~255u);
#pragma unroll
        for (int i = 0; i < 16; ++i) {
            const unsigned cell = 255u - (v[i] & 255u), ca = cell >> 4, cb = cell & 15u;
            const unsigned wa = (ca >> 2) == 0 ? i1p[0] : (ca >> 2) == 1 ? i1p[1] : (ca >> 2) == 2 ? i1p[2] : i1p[3];
            const unsigned wb = (cb >> 2) == 0 ? i2p[0] : (cb >> 2) == 1 ? i2p[1] : (cb >> 2) == 2 ? i2p[2] : i2p[3];
            const unsigned e1 = (wa >> (8 * (ca & 3u))) & 255u, e2 = (wb >> (8 * (cb & 3u))) & 255u;
            ex[i] = (int)(e1 * PKEYS + e2);
            sc[i] = __expf(unord_f(v[i] & ~255u) - s0); den += sc[i];
        }
        const float iden = 1.f / den;
        u32x4 e0, e1v; f32x4 g0, g1;
        e0.x = hh ? ex[8] : ex[0]; e0.y = hh ? ex[9] : ex[1]; e0.z = hh ? ex[10] : ex[2]; e0.w = hh ? ex[11] : ex[3];
        e1v.x = hh ? ex[12] : ex[4]; e1v.y = hh ? ex[13] : ex[5]; e1v.z = hh ? ex[14] : ex[6]; e1v.w = hh ? ex[15] : ex[7];
        g0.x = (hh ? sc[8] : sc[0]) * iden; g0.y = (hh ? sc[9] : sc[1]) * iden; g0.z = (hh ? sc[10] : sc[2]) * iden; g0.w = (hh ? sc[11] : sc[3]) * iden;
        g1.x = (hh ? sc[12] : sc[4]) * iden; g1.y = (hh ? sc[13] : sc[5]) * iden; g1.z = (hh ? sc[14] : sc[6]) * iden; g1.w = (hh ? sc[15] : sc[7]) * iden;
        const size_t ob = tok * PSEL + h * PTOP + 8 * hh;
        *(u32x4*)(EID + ob) = e0; *(u32x4*)(EID + ob + 4) = e1v;
        *(f32x4*)(GATE + ob) = g0; *(f32x4*)(GATE + ob + 4) = g1;
    }
}

constexpr int G_LPP = GCH / 16;
constexpr int G_EPL = 64 / G_LPP;
constexpr int G_NLD = PSEL / G_EPL;
constexpr int G_LOGL = 3;
static_assert(G_LPP == 8 && G_EPL == 8 && G_NLD == 16, "gather geometry");
constexpr int G_TPW = 16;
struct GTask { u32x4 ld[G_NLD]; u32x4 hp; unsigned xo; };
#ifndef PROBE_GMODE
#define PROBE_GMODE 1
#endif
template <bool PB, int MODE>
__device__ __forceinline__ void g_issue(GTask& T, const unsigned char* tab, const unsigned char* HQ, const bf16_t* X, const LAS unsigned short* wids, int c, int m, size_t t0, int g, int i) {
#ifndef PROBE_DUP
#define PROBE_DUP 0
#endif
    const int gdup = (MODE != 0 && PROBE_DUP == 1) ? (g & ~1) : (MODE != 0 && PROBE_DUP == 3) ? (g & ~3) : g;
    const LAS unsigned short* ep = wids + (m * G_EPL + gdup) * G_NLD;
    unsigned ids[G_NLD];
#pragma unroll
    for (int k8 = 0; k8 < G_NLD / 8; ++k8) { const u32x4 p = *(const LAS u32x4*)(ep + 8 * k8);
#pragma unroll
        for (int k = 0; k < 4; ++k) { ids[8 * k8 + 2 * k] = p[k] & 0xffffu; ids[8 * k8 + 2 * k + 1] = p[k] >> 16; } }
    if (MODE != 0 && PROBE_DUP == 2) {
#pragma unroll
        for (int k = 0; k < G_NLD; ++k) ids[k] = ids[k & ~1];
    }
    const unsigned char* base = tab + (size_t)c * NEXP * GCH + 16 * i;
    if (MODE >= 3) {
#pragma unroll
        for (int k = 0; k < G_NLD; ++k) T.ld[k] = (u32x4){ids[k], ids[k] * 3u, ids[k] + 77u, ids[k] ^ 0x55u};
    } else {
#pragma unroll
        for (int k = 0; k < G_NLD; ++k) T.ld[k] = *(const u32x4*)(base + (size_t)ids[k] * GCH);
    }
    const size_t t = t0 + m;
    if (!PB) T.hp = *(const u32x4*)(HQ + t * DM + c * GCH + 16 * i);
    else T.xo = *(const unsigned*)(X + t * DM + c * GCH + 16 * i + 2 * (g & 7));
}
template <int MODE>
__device__ __forceinline__ void g_compute_a(const GTask& T, LAS int* wact, int m, int g, int i, int lane) {
    if (MODE == 2) {
#pragma unroll
        for (int k = 0; k < G_NLD; ++k) asm volatile("" :: "v"(T.ld[k]));
        asm volatile("" :: "v"(T.hp));
        return;
    }
    int s[G_NLD];
#pragma unroll
    for (int k = 0; k < G_NLD; ++k) { int v = 0;
#pragma unroll
        for (int q = 0; q < 4; ++q) v = __builtin_amdgcn_sdot4((int)T.ld[k][q], (int)T.hp[q], v, false);
        s[k] = v; }
#pragma unroll
    for (int st = 0; st < G_LOGL; ++st) {
        const bool bit = (lane >> st) & 1;
#pragma unroll
        for (int mm = 0; mm < (G_NLD >> (st + 1)); ++mm) {
            const int x = bit ? s[2 * mm + 1] : s[2 * mm], y = bit ? s[2 * mm] : s[2 * mm + 1];
            s[mm] = x + __shfl_xor(y, 1 << st);
        }
    }
    LAS int* ap = wact + (m * G_EPL + g) * G_NLD + i;
    __hip_atomic_fetch_add(ap, s[0], __ATOMIC_RELAXED, __HIP_MEMORY_SCOPE_WORKGROUP);
    __hip_atomic_fetch_add(ap + G_LPP, s[1], __ATOMIC_RELAXED, __HIP_MEMORY_SCOPE_WORKGROUP);
}
template <int MODE>
__device__ __forceinline__ void g_compute_b(const GTask& T, const LAS unsigned char* wq, const LAS float* wsc, bf16_t* X, int c, int m, size_t t0, int g, int i, int lane) {
    if (MODE == 2) {
#pragma unroll
        for (int k = 0; k < G_NLD; ++k) asm volatile("" :: "v"(T.ld[k]));
        asm volatile("" :: "v"(T.xo));
        return;
    }
    const u32x4 w4 = *(const LAS u32x4*)(wq + (m * G_EPL + g) * G_NLD);
    int acc[16];
#pragma unroll
    for (int j = 0; j < 16; ++j) acc[j] = 0;
#pragma unroll
    for (int kq = 0; kq < G_NLD / 4; ++kq)
#pragma unroll
        for (int q = 0; q < 4; ++q) {
            const unsigned d0 = T.ld[4 * kq][q], d1 = T.ld[4 * kq + 1][q], d2 = T.ld[4 * kq + 2][q], d3 = T.ld[4 * kq + 3][q];
            const unsigned p0 = __builtin_amdgcn_perm(d1, d0, 0x05010400u), p1 = __builtin_amdgcn_perm(d1, d0, 0x07030602u);
            const unsigned q0 = __builtin_amdgcn_perm(d3, d2, 0x05010400u), q1 = __builtin_amdgcn_perm(d3, d2, 0x07030602u);
            const unsigned t0_ = __builtin_amdgcn_perm(q0, p0, 0x05040100u), t1_ = __builtin_amdgcn_perm(q0, p0, 0x07060302u);
            const unsigned t2_ = __builtin_amdgcn_perm(q1, p1, 0x05040100u), t3_ = __builtin_amdgcn_perm(q1, p1, 0x07060302u);
            acc[4 * q] = __builtin_amdgcn_sdot4((int)t0_, (int)w4[kq], acc[4 * q], false);
            acc[4 * q + 1] = __builtin_amdgcn_sdot4((int)t1_, (int)w4[kq], acc[4 * q + 1], false);
            acc[4 * q + 2] = __builtin_amdgcn_sdot4((int)t2_, (int)w4[kq], acc[4 * q + 2], false);
            acc[4 * q + 3] = __builtin_amdgcn_sdot4((int)t3_, (int)w4[kq], acc[4 * q + 3], false);
        }
#define G_RSTAGE(HALF, LBIT) { const bool bit_ = (lane >> (LBIT)) & 1; _Pragma("unroll") for (int mm = 0; mm < (HALF); ++mm) { \
        const int x_ = bit_ ? acc[mm + (HALF)] : acc[mm], y_ = bit_ ? acc[mm] : acc[mm + (HALF)]; acc[mm] = x_ + __shfl_xor(y_, 1 << (LBIT)); } }
    G_RSTAGE(8, G_LOGL + 2)
    G_RSTAGE(4, G_LOGL + 1)
    G_RSTAGE(2, G_LOGL + 0)
#undef G_RSTAGE
    const float sc = wsc[m];
    if (MODE == 0) {
        const float x0 = bflo(T.xo) + sc * (float)acc[0], x1 = bfhi(T.xo) + sc * (float)acc[1];
        *(unsigned*)(X + (t0 + m) * DM + c * GCH + 16 * i + 2 * (g & 7)) = pk2(x0, x1);
    } else asm volatile("" :: "v"(acc[0]), "v"(acc[1]), "v"(sc));
}

constexpr int GS_LIST = 0, GS_CNT = 65536, GS_ACT = 65536, GS_HN = 131072, GS_WT = 131072, GS_SEG = 256;
struct GTaskA { u32x4 ld[G_NLD]; unsigned ent[G_NLD]; };
template <int PM>
__device__ __forceinline__ void gsort_block(const Ctx& F, const int* EIDb  ) {
    LAS unsigned* cnt = (LAS unsigned*)(F.lds + GS_CNT);
    LAS unsigned* list = (LAS unsigned*)(F.lds + GS_LIST);
    LAS unsigned* wt = (LAS unsigned*)(F.lds + GS_WT);
    const int tid = F.tid, lane = F.lane;
    unsigned er[32];
#pragma unroll
    for (int j = 0; j < 32; ++j) er[j] = (unsigned)EIDb[j * NTHREADS + tid];
#pragma unroll
    for (int j = 0; j < 8; ++j) *(LAS u32x4*)(cnt + (j * NTHREADS + tid) * 4) = (u32x4){0u, 0u, 0u, 0u};
    asm volatile("s_waitcnt lgkmcnt(0)" ::: "memory"); __builtin_amdgcn_s_barrier(); asm volatile("" ::: "memory");
#pragma unroll
    for (int j = 0; j < 32; ++j) { const unsigned r = __hip_atomic_fetch_add(cnt + er[j], 1u, __ATOMIC_RELAXED, __HIP_MEMORY_SCOPE_WORKGROUP); er[j] |= r << 14; }
    asm volatile("s_waitcnt lgkmcnt(0)" ::: "memory"); __builtin_amdgcn_s_barrier(); asm volatile("" ::: "memory");
    u32x4 v[8]; unsigned sum = 0;
#pragma unroll
    for (int j = 0; j < 8; ++j) { v[j] = *(const LAS u32x4*)(cnt + (j * NTHREADS + tid) * 4); sum += (v[j].x + v[j].y) + (v[j].z + v[j].w); }
    unsigned incl = sum;
#pragma unroll
    for (int d = 1; d < 64; d <<= 1) { const unsigned t = __shfl_up(incl, d); if (lane >= d) incl += t; }
    if (lane == 63) wt[F.wave] = incl;
    asm volatile("s_waitcnt lgkmcnt(0)" ::: "memory"); __builtin_amdgcn_s_barrier(); asm volatile("" ::: "memory");
    unsigned run = incl - sum;
#pragma unroll
    for (int w = 0; w < NWAVES - 1; ++w) run += (w < F.wave) ? wt[w] : 0u;
#pragma unroll
    for (int j = 0; j < 8; ++j) { u32x4 o; o.x = run; run += v[j].x; o.y = run; run += v[j].y; o.z = run; run += v[j].z; o.w = run; run += v[j].w; *(LAS u32x4*)(cnt + (j * NTHREADS + tid) * 4) = o; }
    asm volatile("s_waitcnt lgkmcnt(0)" ::: "memory"); __builtin_amdgcn_s_barrier(); asm volatile("" ::: "memory");
#pragma unroll
    for (int j = 0; j < 32; ++j) { const unsigned e = er[j] & 0x3fffu, pos = (PM & 1) ? (unsigned)(j * NTHREADS + tid) : cnt[e] + (er[j] >> 14); list[pos] = (e << 14) | (unsigned)(j * NTHREADS + tid); }
    asm volatile("s_waitcnt lgkmcnt(0)" ::: "memory"); __builtin_amdgcn_s_barrier(); asm volatile("" ::: "memory");
}
template <int PM>
__device__ __forceinline__ void ga_issue(GTaskA& T, const unsigned char* tabc  , const LAS unsigned* lp  , unsigned i16) {
#pragma unroll
    for (int k4 = 0; k4 < G_NLD / 4; ++k4) { const u32x4 p = *(const LAS u32x4*)(lp + 4 * k4); T.ent[4 * k4] = p.x; T.ent[4 * k4 + 1] = p.y; T.ent[4 * k4 + 2] = p.z; T.ent[4 * k4 + 3] = p.w; }
#pragma unroll
    for (int k = 0; k < G_NLD; ++k) { if (PM & 4) T.ld[k] = (u32x4){T.ent[k], T.ent[k] * 3u, T.ent[k] + 77u, T.ent[k] ^ 0x55u}; else T.ld[k] = *(const u32x4*)(tabc + (((T.ent[k] >> 7) & ~127u) + i16)); }
}
template <int PM>
__device__ __forceinline__ void ga_compute(const GTaskA& T, unsigned hbv, const LAS unsigned* lp, LAS int* act, int i, int lane) {
    const unsigned e0 = lp[i], e1 = lp[8 + i];
    int s[G_NLD];
#pragma unroll
    for (int kb = 0; kb < G_NLD; kb += 8) {
        u32x4 hp[8];
#pragma unroll
        for (int k = 0; k < 8; ++k) hp[k] = (PM & 2) ? (u32x4){T.ent[kb + k], T.ent[kb + k] >> 3, T.ent[kb + k] * 5u, T.ent[kb + k] + 1u} : *(const LAS u32x4*)(size_t)((T.ent[kb + k] & 0x3f80u) | hbv);
        asm volatile("" : "+v"(hp[0]), "+v"(hp[1]), "+v"(hp[2]), "+v"(hp[3]), "+v"(hp[4]), "+v"(hp[5]), "+v"(hp[6]), "+v"(hp[7]));
#pragma unroll
        for (int k = 0; k < 8; ++k) { int v = 0;
#pragma unroll
            for (int q = 0; q < 4; ++q) v = __builtin_amdgcn_sdot4((int)T.ld[kb + k][q], (int)hp[k][q], v, false);
            s[kb + k] = v; }
    }
#pragma unroll
    for (int st = 0; st < G_LOGL; ++st) {
        const bool bit = (lane >> st) & 1;
#pragma unroll
        for (int mm = 0; mm < (G_NLD >> (st + 1)); ++mm) {
            const int x = bit ? s[2 * mm + 1] : s[2 * mm], y = bit ? s[2 * mm] : s[2 * mm + 1];
            s[mm] = x + __shfl_xor(y, 1 << st);
        }
    }
    __hip_atomic_fetch_add(act + (e0 & 0x3fffu), s[0], __ATOMIC_RELAXED, __HIP_MEMORY_SCOPE_WORKGROUP);
    __hip_atomic_fetch_add(act + (e1 & 0x3fffu), s[1], __ATOMIC_RELAXED, __HIP_MEMORY_SCOPE_WORKGROUP);
}

constexpr int G_WAVE_LDS = 4096 + 2048 + 64;
static_assert(NWAVES * G_WAVE_LDS <= GS_CNT && GS_ACT + NWAVES * 8192 <= GS_HN && GS_HN + 2 * 16384 <= LDS_BYTES && GCH == 128 && PSEL == 128 && NTHREADS == 512, "gather LDS map");
template <int PM>
__device__ __forceinline__ void gather_a(const Ctx& F, const Args& a, int tb) {
    const unsigned char* EU = F.ws + WS_EU;
    const int* EID = (const int*)(F.ws + WS_EID);
    const unsigned char* HQ = F.ws + WS_H;
    const int lane = F.lane, g = lane / G_LPP, i = lane % G_LPP;
    {
            const size_t tb0 = (size_t)tb * 128;
            gsort_block<PM>(F, EID + tb0 * PSEL);
            if (PM & 8) gsort_block<PM>(F, EID + tb0 * PSEL);
            LAS unsigned char* hnb = F.lds + GS_HN;
            const LAS unsigned* lq = (const LAS unsigned*)(F.lds + GS_LIST) + (F.wave * G_EPL + g) * GS_SEG;
            const unsigned char* hbase = HQ + (tb0 + F.wave * 16) * DM;
#define GA_HN_DMA(c_, buf_) do { int lz_ = lane; asm volatile("" : "+v"(lz_)); const unsigned ho_ = (unsigned)((lz_ >> 3) * DM + 16 * (lz_ & 7)); _Pragma("unroll") for (int r_ = 0; r_ < 2; ++r_) \
        __builtin_amdgcn_global_load_lds((const unsigned*)(hbase + (size_t)(r_ * 8 * DM + (c_) * GCH) + ho_), (LAS unsigned*)(hnb + (buf_) * 16384 + (F.wave * 2 + r_) * 1024), 16, 0, 0); } while (0)
#pragma unroll
            for (int j = 0; j < 8; ++j) *(LAS u32x4*)(F.lds + GS_ACT + (j * NTHREADS + F.tid) * 16) = (u32x4){0u, 0u, 0u, 0u};
            GA_HN_DMA(0, 0);
            asm volatile("s_waitcnt vmcnt(0) lgkmcnt(0)" ::: "memory"); __builtin_amdgcn_s_barrier(); asm volatile("" ::: "memory");
            LAS int* act = (LAS int*)(F.lds + GS_ACT);
            GTaskA A, B;
            const unsigned i16 = 16u * (unsigned)i;
            ga_issue<PM>(A, EU, lq, i16);
            for (int c = 0; c < GNCH; ++c) {
                const unsigned char* tc = EU + (size_t)c * NEXP * GCH;
                const unsigned char* tn = EU + (size_t)(c + 1 < GNCH ? c + 1 : c) * NEXP * GCH;
                const unsigned hb = (unsigned)(GS_HN + (c & 1) * 16384 + 16 * i);
                if (c + 1 < GNCH) GA_HN_DMA(c + 1, (c + 1) & 1);
                for (int j = 0; j < G_TPW; j += 2) {
                    ga_issue<PM>(B, tc, lq + 16 * (j + 1), i16);
                    ga_compute<PM>(A, hb, lq + 16 * j, act, i, lane);
                    if (j + 2 < G_TPW) ga_issue<PM>(A, tc, lq + 16 * (j + 2), i16); else ga_issue<PM>(A, tn, lq, i16);
                    ga_compute<PM>(B, hb, lq + 16 * (j + 1), act, i, lane);
                }
                asm volatile("s_waitcnt vmcnt(16) lgkmcnt(0)" ::: "memory"); __builtin_amdgcn_s_barrier(); asm volatile("" ::: "memory");
            }
#undef GA_HN_DMA
            asm volatile("" :: "v"(A.ld[0]));
            if (F.tid < 32) ((volatile LAS unsigned*)(F.lds + MISC_OFF))[F.tid] = 0u;
            asm volatile("s_waitcnt lgkmcnt(0)" ::: "memory"); __builtin_amdgcn_s_barrier(); asm volatile("" ::: "memory");
        }
}
template <int MODE>
__device__ __forceinline__ void gather_block(const Ctx& F, const Args& a, int l, int tb) {
    const unsigned char* EU = F.ws + WS_EU; const unsigned char* EV = F.ws + WS_EV;
    const float* SCU = (const float*)(F.ws + WS_ESC); const float* SCV = SCU + NEXP;
    const int* EID = (const int*)(F.ws + WS_EID); const float* GATE = (const float*)(F.ws + WS_GATE);
    unsigned char* HQ = F.ws + WS_H; float* HSC = (float*)(F.ws + WS_HSC);
    bf16_t* X = (bf16_t*)(F.ws + WS_XB);
    const float* gnext = (l + 1 < NLAYER) ? a.in[6] + (l + 1) * DM : a.in[21];
    if (MODE == 4) return;
    const int lane = F.lane, g = lane / G_LPP, i = lane % G_LPP;
    LAS unsigned char* wl = F.lds + F.wave * G_WAVE_LDS;
    LAS int* wact = (LAS int*)(F.lds + GS_ACT + F.wave * 8192);
    LAS unsigned short* wids = (LAS unsigned short*)wl;
    LAS unsigned char* wq = wl + 4096;
    LAS float* wsc = (LAS float*)(wl + 4096 + 2048);
    {
        const int tg = tb * NWAVES + F.wave;
        const size_t t0 = (size_t)tg * G_TPW;
#pragma unroll
        for (int m = 0; m < G_TPW; ++m) {
#pragma unroll
            for (int hh = 0; hh < 2; ++hh) {
                const int e = 64 * hh + lane, eg = e % G_EPL, ek = e / G_EPL;
                wids[(m * G_EPL + eg) * G_NLD + ek] = (unsigned short)EID[(t0 + m) * PSEL + e];
            }
        }
        asm volatile("s_waitcnt lgkmcnt(0)" ::: "memory");
        for (int mb = 0; mb < G_TPW; mb += 4) {
            int ex[4][2]; float gt[4][2], hs[4];
#pragma unroll
            for (int r = 0; r < 4; ++r) { hs[r] = HSC[t0 + mb + r];
#pragma unroll
                for (int hh = 0; hh < 2; ++hh) { ex[r][hh] = EID[(t0 + mb + r) * PSEL + 64 * hh + lane]; gt[r][hh] = GATE[(t0 + mb + r) * PSEL + 64 * hh + lane]; } }
            float su[4][2], sv[4][2];
#pragma unroll
            for (int r = 0; r < 4; ++r)
#pragma unroll
                for (int hh = 0; hh < 2; ++hh) { su[r][hh] = SCU[ex[r][hh]]; sv[r][hh] = SCV[ex[r][hh]]; }
#pragma unroll
            for (int r = 0; r < 4; ++r) {
                const int m = mb + r;
                float wv[2]; float mx = 0.f;
#pragma unroll
                for (int hh = 0; hh < 2; ++hh) {
                    const int e = 64 * hh + lane, eg = e % G_EPL, ek = e / G_EPL;
                    const float act = (float)wact[m * PSEL + e] * (su[r][hh] * hs[r]);
                    wv[hh] = gt[r][hh] * gelu1(act) * sv[r][hh];
                    mx = fmaxf(mx, fabsf(wv[hh]));
                }
                mx = wave_max(mx);
                const float sc = mx > 0.f ? mx * (1.f / 127.f) : 1.f, is = 1.f / sc;
#pragma unroll
                for (int hh = 0; hh < 2; ++hh) {
                    const int e = 64 * hh + lane, eg = e % G_EPL, ek = e / G_EPL;
                    wq[(m * G_EPL + eg) * G_NLD + ek] = (unsigned char)((int)rintf(wv[hh] * is) & 255);
                }
                if (lane == 0) wsc[m] = sc;
            }
        }
        asm volatile("s_waitcnt lgkmcnt(0)" ::: "memory");
        {
            GTask A, B;
            g_issue<true, MODE>(A, EV, HQ, X, wids, 0, 0, t0, g, i);
            for (int c = 0; c < GNCH; ++c) {
                for (int m = 0; m < G_TPW; m += 2) {
                    g_issue<true, MODE>(B, EV, HQ, X, wids, c, m + 1, t0, g, i);
                    g_compute_b<MODE>(A, wq, wsc, X, c, m, t0, g, i, lane);
                    { const int m2 = (m + 2 < G_TPW) ? m + 2 : 0, c2 = (m + 2 < G_TPW) ? c : (c + 1 < GNCH ? c + 1 : c);
                      g_issue<true, MODE>(A, EV, HQ, X, wids, c2, m2, t0, g, i); }
                    g_compute_b<MODE>(B, wq, wsc, X, c, m + 1, t0, g, i, lane);
                }
            }
            asm volatile("" :: "v"(A.ld[0]));
        }
        if (MODE != 0) return;
        asm volatile("s_waitcnt vmcnt(0)" ::: "memory");
        for (int mb = 0; mb < G_TPW; mb += 4) {
            float vv[4][16];
            load_xb_rows<4, true>(vv, X + (t0 + mb) * DM, lane);
#pragma unroll
            for (int r = 0; r < 4; ++r) {
                const int m = mb + r;
                rms_inplace16(vv[r], gnext, lane);
                if (l + 1 < NLAYER) store_i8_row16(vv[r], HQ + (t0 + m) * DM, HSC + t0 + m, lane);
                else {
                    float* orow = a.out + (t0 + m) * DM;
#pragma unroll
                    for (int q = 0; q < 2; ++q) { *(f32x4*)(orow + 512 * q + 8 * lane) = (f32x4){vv[r][8 * q], vv[r][8 * q + 1], vv[r][8 * q + 2], vv[r][8 * q + 3]};
                        *(f32x4*)(orow + 512 * q + 8 * lane + 4) = (f32x4){vv[r][8 * q + 4], vv[r][8 * q + 5], vv[r][8 * q + 6], vv[r][8 * q + 7]}; }
                }
            }
        }
    }
}

constexpr int PH_PER_LAYER = 8, NPHASE = 2 + NLAYER * PH_PER_LAYER;
#ifndef PMASK
#define PMASK 0xFFFF
#endif
#define PM(j) ((PMASK >> (j)) & 1)
#ifndef PROBE_PH
#define PROBE_PH -1
#endif
#ifndef PROBE_REPS
#define PROBE_REPS 1
#endif
#define NREP(k) ((PROBE_PH == (k)) ? 1 + PROBE_REPS : 1)
__global__ void __launch_bounds__(NTHREADS, 2) fwd(Args a) {
    extern __shared__ __attribute__((aligned(16))) unsigned char lds_raw[];
    volatile LAS unsigned* MISC = (volatile LAS unsigned*)((LAS unsigned char*)lds_raw + MISC_OFF);
    const int wv = __builtin_amdgcn_readfirstlane((int)threadIdx.x >> 6);
    if (threadIdx.x < 32) MISC[threadIdx.x] = 0u;
    __syncthreads();
#ifndef MK_SINGLE
#define MK_SINGLE 1
#endif
    const bool single = MK_SINGLE ? true : (a.ph_hi - a.ph_lo) > 1;
    XcdBarrier bar; bar.bar = (unsigned*)(a.ws + WS_CTL); bar.x = 0; bar.st = MISC + 8; bar.wv = wv;
    if (single) bar = xcd_barrier_post((unsigned*)(a.ws + WS_CTL), MISC + 8, wv);
    const int lo = a.ph_lo, hi = a.ph_hi;
#define IN(k) (MK_SINGLE ? true : (lo <= (k) && (k) < hi))
#ifndef PROBE_BAR
#define PROBE_BAR 0
#endif
#define SEAM(k) do { if (IN(k) && IN((k) + 1)) { xcd_barrier(bar); if (PROBE_BAR) xcd_barrier(bar); } } while (0)

    if (PM(15) && IN(0)) for (int rep = 0; rep < NREP(15); ++rep) { MKCTX(F, a); p0a_prologue(F, a); }
    SEAM(0);
    if (PM(15) && IN(1)) { MKCTX(F, a); p0b_prologue(F, a); }
    SEAM(1);
    for (int l = 0; l < NLAYER; ++l) {
        const int pb = 2 + l * PH_PER_LAYER;
        if (PM(0) && IN(pb + 0)) for (int rep = 0; rep < NREP(0); ++rep) {
            MKCTX(F, a);
            if (l > 0) convert_experts(F, a, l);
            pg8::Gemm g{(const bf16_t*)(F.ws + WS_H), (const bf16_t*)(F.ws + WS_WIN + (size_t)l * 2048 * DM), DM / 2, DM / 2, DM / 2};
            pg8::StaticOrder S; S.init(TOK, 2048, F.G, F.bid);
            EpiQKVU E{(bf16_t*)(F.ws + WS_Q), (bf16_t*)(F.ws + WS_K), (bf16_t*)(F.ws + WS_V), (bf16_t*)(F.ws + WS_UX), (const float*)(F.ws + WS_HSC), (const float*)(F.ws + WS_WSC) + WSC_IN + l * 2048};
            pg8::gemm_phase(F.lds, F.tid, g, S, E);
        }
        SEAM(pb + 0);
#ifndef ATT_A
#define ATT_A 5
#endif
#ifndef PROBE_P1
#define PROBE_P1 0
#endif
        if (PM(1) && IN(pb + 1)) for (int rep = 0; rep < NREP(1); ++rep) {
            if (!(PROBE_P1 == 1 && rep < NREP(1) - 1)) {
              { MKCTX(F, a);
                pg8::Gemm g{(const bf16_t*)(F.ws + WS_UX), (const bf16_t*)(F.ws + WS_W1) + (size_t)l * SG * N1 * K1, K2, K1, K1};
                pg8::BatchOrder S; S.init(ROWS_G / 256, N1 / 256, SG, F.G, F.bid);
                EpiE E{(float*)(F.ws + WS_E)};
                pg8::gemm_phase(F.lds, F.tid, g, S, E);
                asm volatile("s_waitcnt vmcnt(0)" ::: "memory");
                __syncthreads();
                for (int L = F.bid; L < SG * 4; L += F.G) carry_unit(F, a, l, L >> 2, L & 3);
                asm volatile("s_waitcnt vmcnt(0)" ::: "memory");
                __syncthreads();
              }
              { MKCTX(F, a);
                pg8::Gemm g{(const bf16_t*)(F.ws + WS_UX), (const bf16_t*)(F.ws + WS_M2) + (size_t)l * SG * N2 * K2, K2, K2, K2};
                pg8::LocalPairOrder S; S.init(F.G, F.bid);
                EpiY E{(bf16_t*)(F.ws + WS_Y)};
                pg8::gemm_phase(F.lds, F.tid, g, S, E);
              }
            }
            if (!(PROBE_P1 == 2 && rep < NREP(1) - 1)) { MKCTX(F, a);
              if (F.G == 256) { const int nA = ATT_A, nB = 24 - ATT_A; const int u0 = F.bid < 128 ? nA * F.bid : 128 * nA + nB * (F.bid - 128), nu = F.bid < 128 ? nA : nB; attn_phase(F, a, u0, u0 + nu, 1); }
              else attn_phase(F, a, F.bid, 3 * 1024, F.G);
            }
        }
        SEAM(pb + 1);
        if (PM(2) && IN(pb + 2)) for (int rep = 0; rep < NREP(2); ++rep) {
            MKCTX(F, a);
            pg8::Gemm g{(const bf16_t*)(F.ws + WS_Y), (const bf16_t*)(F.ws + WS_WGLU) + (size_t)l * 1024 * SW, SW, SW, SW};
            pg8::StaticOrder S; S.init(TOK, 1024, F.G, F.bid);
            EpiGLU E{(bf16_t*)(F.ws + WS_SSM)};
            pg8::gemm_phase(F.lds, F.tid, g, S, E);
        }
        SEAM(pb + 2);
        if (PM(3) && IN(pb + 3)) for (int rep = 0; rep < NREP(3); ++rep) { MKCTX(F, a); mixprep_phase(F, a, l); }
        SEAM(pb + 3);
        if (PM(4) && IN(pb + 4)) for (int rep = 0; rep < NREP(4); ++rep) {
            MKCTX(F, a);
            pg8::Gemm g{(const bf16_t*)(F.ws + WS_H), (const bf16_t*)(F.ws + WS_WOUT + (size_t)l * DM * DM), DM / 2, DM / 2, DM / 2};
            pg8::StaticOrder S; S.init(TOK, DM, F.G, F.bid);
            EpiRes E{(bf16_t*)(F.ws + WS_XB), (const float*)(F.ws + WS_HSC), (const float*)(F.ws + WS_WSC) + WSC_OUT + l * DM, rep == NREP(4) - 1};
            pg8::gemm_phase(F.lds, F.tid, g, S, E);
        }
        SEAM(pb + 4);
        if (PM(5) && IN(pb + 5)) for (int rep = 0; rep < NREP(5); ++rep) {
            MKCTX(F, a);
            for (int m = (F.bid * NWAVES + F.wave) * 4; m < TOK; m += F.G * NWAVES * 4) rms_xb_rows_to_i8<4>((const bf16_t*)(F.ws + WS_XB) + (size_t)m * DM, a.in[7] + l * DM, F.ws + WS_H + (size_t)m * DM, (float*)(F.ws + WS_HSC) + m, F.lane);
        }
        SEAM(pb + 5);
        if (PM(6) && IN(pb + 6)) for (int rep = 0; rep < NREP(6); ++rep) {
            MKCTX(F, a);
            pg8::Gemm g{(const bf16_t*)(F.ws + WS_H), (const bf16_t*)(F.ws + WS_WQ + (size_t)l * DM * DM), DM / 2, DM / 2, DM / 2};
            pg8::StaticOrder S; S.init(TOK, DM, F.G, F.bid);
            EpiBf E{(bf16_t*)(F.ws + WS_QB), DM, (const float*)(F.ws + WS_HSC), (const float*)(F.ws + WS_WSC) + WSC_Q + l * DM};
            pg8::gemm_phase(F.lds, F.tid, g, S, E);
        }
        SEAM(pb + 6);
        if (PM(7) && IN(pb + 7)) for (int rep = 0; rep < NREP(7); ++rep) {
            for (int tb = blockIdx.x; tb < TOK / 128; tb += gridDim.x) {
                { MKCTX(F, a); topk_block(F, a, l, tb); }
                asm volatile("s_waitcnt vmcnt(0)" ::: "memory");
                __syncthreads();
#ifndef PROBE_GA
#define PROBE_GA 0
#endif
                { MKCTX(F, a); if (rep == NREP(7) - 1) gather_a<0>(F, a, tb); else gather_a<PROBE_GA>(F, a, tb); }
                { MKCTX(F, a); if (rep == NREP(7) - 1) gather_block<0>(F, a, l, tb); else gather_block<PROBE_GMODE>(F, a, l, tb); }
                __syncthreads();
            }
        }
        SEAM(pb + 7);
    }
#undef IN
#undef SEAM
}

static int t5_bucket(int rel) {
    const int half = 16, max_exact = 8;
    const int n = rel < 0 ? -rel : rel;
    int large = max_exact + (int)(std::log((double)(n > 1 ? n : 1) / (double)max_exact) / std::log(1024.0 / (double)max_exact) * (double)(half - max_exact));
    if (large > half - 1) large = half - 1;
    return (rel > 0 ? half : 0) + (n < max_exact ? n : large);
}

extern "C" void kernel_launch(void* const* d_in, const int* in_sizes, int n_in, void* d_out, int out_size, void* d_ws, size_t ws_size, hipStream_t stream) {
    static int grid = 0;
    if (grid == 0) {
        if (n_in != 22 || out_size != TOK * DM || ws_size < WS_END) { fprintf(stderr, "kernel_launch: unexpected shapes (n_in %d out %d ws %zu)\n", n_in, out_size, ws_size); grid = -1; return; }
        int dev = 0, cus = 0, per_cu = 0;
        if (hipGetDevice(&dev) != hipSuccess || hipDeviceGetAttribute(&cus, hipDeviceAttributeMultiprocessorCount, dev) != hipSuccess) { grid = -1; return; }
        if (hipFuncSetAttribute((const void*)fwd, hipFuncAttributeMaxDynamicSharedMemorySize, LDS_BYTES) != hipSuccess) { fprintf(stderr, "kernel_launch: hipFuncSetAttribute failed\n"); grid = -1; return; }
        if (hipOccupancyMaxActiveBlocksPerMultiprocessor(&per_cu, (const void*)fwd, NTHREADS, LDS_BYTES) != hipSuccess || per_cu < 1) fprintf(stderr, "kernel_launch: occupancy query says %d\n", per_cu);
        (void)hipGetLastError();
        grid = cus;
    }
    if (grid < 0) return;
    hipMemsetAsync((char*)d_ws + WS_CTL, 0, CTL_ZERO_BYTES, stream);
    Args a; memset(&a, 0, sizeof(a));
    for (int i = 0; i < 22; ++i) a.in[i] = (const float*)d_in[i];
    a.out = (float*)d_out; a.ws = (unsigned char*)d_ws;
    for (int p = 0; p < 3; ++p) { const int d = p == 0 ? 1 : (p == 1 ? 4 : 16); for (int i = 0; i < 129; ++i) a.bkt[p][i] = (signed char)t5_bucket((i - 64) * d); }
#ifndef MK_SINGLE
#define MK_SINGLE 1
#endif
    if (MK_SINGLE) {
        a.ph_lo = 0; a.ph_hi = NPHASE;
        hipLaunchKernelGGL(fwd, dim3(grid), dim3(NTHREADS), LDS_BYTES, stream, a);
    } else {
        for (int ph = 0; ph < NPHASE; ++ph) { a.ph_lo = ph; a.ph_hi = ph + 1; hipLaunchKernelGGL(fwd, dim3(grid), dim3(NTHREADS), LDS_BYTES, stream, a); }
    }
}
```

```cpp
#include <hip/hip_runtime.h>
#include <cmath>
#include <cstdio>
#include <cstring>
#include <type_traits>

#define LAS __attribute__((address_space(3)))
#define GAS __attribute__((address_space(1)))
typedef unsigned short bf16_t;
typedef short bf16x8 __attribute__((ext_vector_type(8)));
typedef short s16x4 __attribute__((ext_vector_type(4)));
typedef float f32x4 __attribute__((ext_vector_type(4)));
typedef float f32x2 __attribute__((ext_vector_type(2)));
typedef float f32x16 __attribute__((ext_vector_type(16)));
typedef unsigned u32x4 __attribute__((ext_vector_type(4)));
typedef unsigned u32x2 __attribute__((ext_vector_type(2)));
typedef int i32x4 __attribute__((ext_vector_type(4)));
typedef __bf16 bf16x2_t __attribute__((ext_vector_type(2)));

constexpr int NB = 8, SEQ = 4096, DM = 1024, TOK = NB * SEQ, NLAYER = 2;
constexpr int AW = 512, NH = 8, HD = 64, SW = 512, SG = 32, SC = 16, SP = 64;
constexpr int CL = 32;
constexpr int NCHUNK = SEQ / CL;
constexpr int ROWS_G = NB * NCHUNK;
constexpr int K2 = CL * SC + 4 * SP;
constexpr int N2 = CL * SC;
constexpr int K1 = CL * SC;
constexpr int N1 = 4 * SP;
constexpr int PH = 8, PKEYS = 128, PQD = 128, PTOP = 16, NEXP = PKEYS * PKEYS, PSEL = PH * PTOP;
constexpr float EPS = 1e-6f;
constexpr float LOG2E = 1.4426950408889634f, LN2 = 0.6931471805599453f;

constexpr size_t MiB = 1u << 20;
constexpr size_t WS_CTL = 0, CTL_ZERO_BYTES = 64 * 1024;
constexpr size_t WS_SK = 1 * MiB;
constexpr size_t WS_LAML = 1 * MiB + 512 * 1024;
constexpr size_t WS_ESC = 1 * MiB + 640 * 1024;
constexpr size_t WS_HSC = 1 * MiB + 768 * 1024;
constexpr size_t WS_WSC = 1 * MiB + 896 * 1024;
constexpr size_t WS_AQ = 48 * 1024;
constexpr size_t WS_WMAX = 16 * 1024;
constexpr int WSC_IN = 0, WSC_OUT = 2 * 2048, WSC_Q = 2 * 2048 + 2 * 1024;
constexpr size_t WS_WIN = 2 * MiB;
constexpr size_t WS_WGLU = 10 * MiB;
constexpr size_t WS_WOUT = 12 * MiB;
constexpr size_t WS_WQ = 16 * MiB;
constexpr size_t WS_W1 = 20 * MiB;
constexpr size_t WS_M2 = 36 * MiB;
constexpr size_t WS_EU = 84 * MiB;
constexpr size_t WS_EV = 100 * MiB;
constexpr size_t WS_H = 116 * MiB;
constexpr size_t WS_XB = 148 * MiB;
constexpr size_t WS_Q = 212 * MiB, WS_K = 244 * MiB, WS_V = 276 * MiB;
constexpr size_t WS_QB = 212 * MiB;
constexpr size_t WS_EID = 276 * MiB, WS_GATE = 292 * MiB;
constexpr size_t WS_UX = 308 * MiB;
constexpr size_t WS_SSM = 308 * MiB;
constexpr size_t WS_E = 356 * MiB;
constexpr size_t WS_Y = 116 * MiB;
constexpr size_t WS_OP = 388 * MiB;
constexpr size_t WS_LSE = 484 * MiB;
constexpr size_t WS_OSC = 487 * MiB;
constexpr size_t WS_END = 490 * MiB;

constexpr int RING_BYTES = 131072;
constexpr int LDS_BYTES = 163840;
constexpr int MISC_OFF = LDS_BYTES - 512;
constexpr int NWAVES = 8, NTHREADS = 512;

__device__ __forceinline__ unsigned f2bf(float f) { unsigned u = __builtin_bit_cast(unsigned, f); return (u + 0x7fffu + ((u >> 16) & 1u)) >> 16; }
__device__ __forceinline__ unsigned pk2(float lo, float hi) { f32x2 v = {lo, hi}; bf16x2_t b = __builtin_convertvector(v, bf16x2_t); return __builtin_bit_cast(unsigned, b); }
__device__ __forceinline__ float bflo(unsigned w) { return __builtin_bit_cast(float, w << 16); }
__device__ __forceinline__ float bfhi(unsigned w) { return __builtin_bit_cast(float, w & 0xffff0000u); }
template <int CTRL> __device__ __forceinline__ float dppf(float v) { return __builtin_bit_cast(float, __builtin_amdgcn_update_dpp(0, __builtin_bit_cast(int, v), CTRL, 0xf, 0xf, false)); }
__device__ __forceinline__ float wave_sum(float v) {
    v += dppf<0xB1>(v); v += dppf<0x4E>(v); v += dppf<0x141>(v); v += dppf<0x140>(v);
    { const unsigned a = __builtin_bit_cast(unsigned, v); const auto r = __builtin_amdgcn_permlane16_swap(a, a, false, false); const unsigned r0 = r[0], r1 = r[1]; v = __builtin_bit_cast(float, r0) + __builtin_bit_cast(float, r1); }
    { const unsigned a = __builtin_bit_cast(unsigned, v); const auto r = __builtin_amdgcn_permlane32_swap(a, a, false, false); const unsigned r0 = r[0], r1 = r[1]; v = __builtin_bit_cast(float, r0) + __builtin_bit_cast(float, r1); }
    return v;
}
__device__ __forceinline__ float gelu1(float v) {
    const float av = fabsf(v), d = av * 0.2316418882f + 1.0f;
    const float t = __builtin_amdgcn_rcpf(d);
    float q = t * 0.5307027145f + (-0.7265760135f); q = q * t + 0.7107068705f; q = q * t + (-0.142248368f); q = q * t + 0.127414796f; q = q * t;
    const float e = __builtin_amdgcn_exp2f((v * v) * (-0.72134752044f));
    const float m = v * (q * e);
    return v < 0.f ? m : v - m;
}

#define XB_TMO      128
#define XB_XCNT(j)  (256  + 64 * (j))
#define XB_XSUB(j)  (1280 + 64 * (j))
#define XB_XGEN(j)  (2304 + 64 * (j))
#define XB_TOP      3328
#define XB_TOPGEN   3392
#define XCD_BAR_WORDS 3456
#define XB_SPIN_CAP (1u << 22)
__device__ __forceinline__ unsigned xb_ld(unsigned* p)              { return __hip_atomic_load(p, __ATOMIC_RELAXED, __HIP_MEMORY_SCOPE_AGENT); }
__device__ __forceinline__ unsigned xb_add(unsigned* p, unsigned v) { return __hip_atomic_fetch_add(p, v, __ATOMIC_RELAXED, __HIP_MEMORY_SCOPE_AGENT); }
__device__ __forceinline__ unsigned xb_xcc_id() { return (unsigned)__builtin_amdgcn_s_getreg((3 << 11) | 20) & 0xFu; }
#define XB_SPIN(cond, bar) do { unsigned _sp = 0; while (cond) { __builtin_amdgcn_s_sleep(1); \
    if ((++_sp & 255u) == 0u) { if (xb_ld(&(bar)[XB_TMO])) break; if (_sp > XB_SPIN_CAP) { atomicAdd(&(bar)[XB_TMO], 1u); break; } } } } while (0)
__device__ __forceinline__ int lane_id() { int r; asm volatile("v_mbcnt_lo_u32_b32 %0, -1, 0\n\tv_mbcnt_hi_u32_b32 %0, -1, %0" : "=v"(r)); return r; }
struct XcdBarrier { unsigned* bar; unsigned x; volatile LAS unsigned* st; int wv; };
__device__ __forceinline__ XcdBarrier xcd_barrier_post(unsigned* bar, volatile LAS unsigned* st, int wv) {
    XcdBarrier b; b.bar = bar; b.x = xb_xcc_id(); b.st = st; b.wv = wv;
    if (wv == 0 && lane_id() == 0) (void)xb_add(&bar[XB_XCNT(b.x)], 1u);
    return b;
}
__device__ __forceinline__ void xcd_barrier_complete(unsigned* bar, unsigned x, unsigned& nloc, unsigned& nx) {
    const unsigned G = gridDim.x * gridDim.y * gridDim.z;
    unsigned sum, cnt, mine, sp = 0u;
    for (;;) {
        sum = 0u; cnt = 0u; mine = 0u;
#pragma unroll
        for (unsigned j = 0; j < 16; ++j) { const unsigned c = xb_ld(&bar[XB_XCNT(j)]); sum += c; cnt += (c > 0u) ? 1u : 0u; mine = (j == x) ? c : mine; }
        if (sum == G) break;
        __builtin_amdgcn_s_sleep(1);
        if ((++sp & 255u) == 0u) { if (xb_ld(&bar[XB_TMO])) break; if (sp > XB_SPIN_CAP) { atomicAdd(&bar[XB_TMO], 1u); break; } }
    }
    nloc = mine > 0u ? mine : 1u; nx = cnt > 0u ? cnt : 1u;
}
__device__ __forceinline__ void xcd_barrier(const XcdBarrier& b) {
    asm volatile("s_waitcnt vmcnt(0)" ::: "memory");
    __syncthreads();
    if (b.wv == 0 && lane_id() == 0) {
        unsigned* bar = b.bar;
        __builtin_amdgcn_s_waitcnt(0);
        unsigned nloc = b.st[0], nx = b.st[1];
        if (nloc == 0u) { xcd_barrier_complete(bar, b.x, nloc, nx); b.st[0] = nloc; b.st[1] = nx; }
        const unsigned old = xb_add(&bar[XB_XSUB(b.x)], 1u);
        const unsigned gen = old / nloc;
        if (old + 1u == (gen + 1u) * nloc) {
            __builtin_amdgcn_fence(__ATOMIC_RELEASE, "agent");
            asm volatile("s_waitcnt vmcnt(0)" ::: "memory");
            const unsigned og = xb_add(&bar[XB_TOP], 1u);
            const unsigned tg = og / nx;
            if (og + 1u == (tg + 1u) * nx) xb_add(&bar[XB_TOPGEN], 1u);
            else XB_SPIN(xb_ld(&bar[XB_TOPGEN]) == tg, bar);
            __builtin_amdgcn_fence(__ATOMIC_ACQUIRE, "agent");
            xb_add(&bar[XB_XGEN(b.x)], 1u);
            asm volatile("s_waitcnt vmcnt(0)" ::: "memory");
        } else {
            XB_SPIN(xb_ld(&bar[XB_XGEN(b.x)]) == gen, bar);
            __builtin_amdgcn_fence(__ATOMIC_ACQUIRE, "agent");
            asm volatile("s_waitcnt vmcnt(0)" ::: "memory");
        }
    }
    __syncthreads();
}

namespace pg8 {
constexpr int BM = 256, BK = 64, HALF = 128, HTB = HALF * BK * 2, STAGE_BYTES = 8 * HTB, NXCD = 8, WGM = 8;
__host__ __device__ __forceinline__ int lds_byte(int r, int c) { const int st = (r >> 4) * 2 + (c >> 5), rr = r & 15, cc = c & 31, ob = rr * 64 + cc * 2; return st * 1024 + (ob ^ (((ob >> 9) & 1) << 5)); }
__host__ __device__ __forceinline__ void stage_rc(int b, int& R, int& C) { const int st = b / 1024, sb = b % 1024, swz = sb ^ (((sb >> 9) & 1) << 5); R = (st >> 1) * 16 + swz / 64; C = (st & 1) * 32 + (swz % 64) / 2; }
__host__ __device__ __forceinline__ int perm32(int rho) { const int n = rho >> 4, i = rho & 15; return 8 * (i >> 2) + 4 * n + (i & 3); }
__host__ __device__ __forceinline__ int perm4(int R) { return 32 * (R >> 5) + 2 * (R & 15) + ((R >> 4) & 1); }
__host__ __device__ __forceinline__ int perm3(int R) { return 64 * (R >> 5) + 4 * (R & 15) + ((R >> 4) & 1); }
__host__ __device__ __forceinline__ int perm2(int R) { return 64 * (R >> 5) + 16 * ((R >> 2) & 3) + 4 * ((R >> 4) & 1) + (R & 3); }
struct Unit { int pm, pn, ord; };
struct Gemm { const bf16_t* A; const bf16_t* Bt; int lda, ldb, K; };
struct StaticOrder {
    int nM, nN, nwg, G, c;
    __device__ void init(int M, int N, int G_, int c_) { nM = M / BM; nN = N / BM; nwg = nM * nN; G = G_; c = c_; }
    __device__ bool next(int i, Unit& u) const {
        const long L = (long)i * G + c; if (L >= nwg) return false;
        int wgid = (int)L; { const int q = nwg / NXCD, r = nwg % NXCD, xcd = wgid % NXCD, off = wgid / NXCD; wgid = (xcd < r ? xcd * (q + 1) : r * (q + 1) + (xcd - r) * q) + off; }
        const int nig = WGM * nN, gid = wgid / nig, fm = gid * WGM, gsz = (nM - fm) < WGM ? (nM - fm) : WGM;
        u.pm = fm + ((wgid % nig) % gsz); u.pn = (wgid % nig) / gsz; return true;
    }
    __device__ __forceinline__ void a_ready(const Unit&) const {}
    __device__ __forceinline__ void done(const Unit&) const {}
};
struct BatchOrder {
    int nMl, nNl, ngrp, G, c;
    __device__ void init(int nMl_, int nNl_, int ngrp_, int G_, int c_) { nMl = nMl_; nNl = nNl_; ngrp = ngrp_; G = G_; c = c_; }
    __device__ bool next(int i, Unit& u) const {
        const long L = (long)i * G + c; if (L >= (long)ngrp * nMl * nNl) return false;
        const int per = nMl * nNl, g = (int)L / per, r = (int)L % per;
        u.pm = g * nMl + r / nNl; u.pn = g * nNl + r % nNl; return true;
    }
    __device__ __forceinline__ void a_ready(const Unit&) const {}
    __device__ __forceinline__ void done(const Unit&) const {}
};

__device__ __forceinline__ f32x4 mma16(bf16x8 a, bf16x8 b, f32x4 c) { return __builtin_amdgcn_mfma_f32_16x16x32_bf16(a, b, c, 0, 0, 0); }
__device__ __forceinline__ i32x4 mma16(bf16x8 a, bf16x8 b, i32x4 c) { return __builtin_amdgcn_mfma_i32_16x16x64_i8(__builtin_bit_cast(i32x4, a), __builtin_bit_cast(i32x4, b), c, 0, 0, 0); }
struct LocalPairOrder {
    int G, c;
    __device__ void init(int G_, int c_) { G = G_; c = c_; }
    __device__ bool next(int i, Unit& u) const {
        const int L = c + (i >> 1) * G; if (L >= 128) return false;
        u.pm = L; u.pn = (L >> 2) * 2 + (i & 1); return true;
    }
    __device__ __forceinline__ void a_ready(const Unit&) const {}
    __device__ __forceinline__ void done(const Unit&) const {}
};
template <class Epi, class Sched>
__device__ __forceinline__ void gemm_phase(LAS unsigned char* lds, const int tid, const Gemm g, const Sched& S, const Epi& E) {
    typedef typename std::conditional<Epi::I8, i32x4, f32x4>::type AccV;
    const int wid = __builtin_amdgcn_readfirstlane(tid >> 6), lane = tid & 63, wr = wid >> 2, wc = wid & 3, fr = lane & 15, fq = lane >> 4;
    const int K = g.K, nt = K / BK;
    unsigned voffA[2], voffB[2];
#pragma unroll
    for (int i = 0; i < 2; ++i) { int R, C; stage_rc(tid * 16 + i * 8192, R, C); const int Rb = Epi::PERM == 4 ? perm4(R) : Epi::PERM == 3 ? perm3(R) : Epi::PERM == 2 ? perm2(R) : Epi::PERM == 1 ? ((R & ~31) + perm32(R & 31)) : R;
        voffA[i] = (unsigned)(R * g.lda + C) * 2u; voffB[i] = (unsigned)(Rb * g.ldb + C) * 2u; }
    const size_t kstep = (size_t)(BK * 2);
    const size_t hA = (size_t)HALF * g.lda * 2, hB = (size_t)(Epi::PERM == 3 ? 2 : Epi::PERM == 2 ? 8 : HALF) * g.ldb * 2;
    const size_t tA = 2 * hA, tB = (size_t)BM * g.ldb * 2;
    const unsigned ldsw = (unsigned)wid * 1024u;
    const int aoff = lds_byte(wr * 64 + fr, fq * 8), boff = lds_byte(wc * 32 + fr, fq * 8);
#define PG8_SA(b, h) (((b) * 2 + (h)) * HTB)
#define PG8_SB(b, h) ((4 + (b) * 2 + (h)) * HTB)
#define PG8_STAGE(bufoff, gbase, voff) do { _Pragma("unroll") for (int _i = 0; _i < 2; ++_i) \
        __builtin_amdgcn_global_load_lds((const unsigned*)((const char*)(gbase) + (voff)[_i]), (LAS unsigned*)(lds + (bufoff) + ldsw + _i * 8192), 16, 0, 0); } while (0)
#define PG8_LDA(dst, b, h) do { _Pragma("unroll") for (int m = 0; m < 4; ++m) _Pragma("unroll") for (int k = 0; k < 2; ++k) dst[m][k] = *(const LAS bf16x8*)(lds + PG8_SA(b, h) + aoff + m * 2048 + k * 1024); } while (0)
#define PG8_LDB(dst, b, h) do { _Pragma("unroll") for (int n = 0; n < 2; ++n) _Pragma("unroll") for (int k = 0; k < 2; ++k) dst[n][k] = *(const LAS bf16x8*)(lds + PG8_SB(b, h) + boff + n * 2048 + k * 1024); } while (0)
#define PG8_MMA(ai, bj, At, Bt) do { __builtin_amdgcn_s_setprio(1); _Pragma("unroll") for (int m = 0; m < 4; ++m) _Pragma("unroll") for (int n = 0; n < 2; ++n) _Pragma("unroll") for (int k = 0; k < 2; ++k) \
        acc[ai][bj][m][n] = Epi::NT ? mma16(At[m][k], Bt[n][k], acc[ai][bj][m][n]) : mma16(Bt[n][k], At[m][k], acc[ai][bj][m][n]); __builtin_amdgcn_s_setprio(0); } while (0)
#define PG8_WAIT_V(n) asm volatile("s_waitcnt vmcnt(" #n ")" ::: "memory")
#define PG8_WAIT_L(n) asm volatile("s_waitcnt lgkmcnt(" #n ")" ::: "memory")
#define PG8_BAR __builtin_amdgcn_s_barrier()
#define PG8_SCHED __builtin_amdgcn_sched_barrier(0)
    Unit cur, nxt; int ui = 0;
    if (!S.next(0, cur)) return;
    AccV acc[2][2][4][2];
#pragma unroll
    for (int a = 0; a < 2; ++a)
#pragma unroll
        for (int b = 0; b < 2; ++b)
#pragma unroll
            for (int m = 0; m < 4; ++m)
#pragma unroll
                for (int n = 0; n < 2; ++n) acc[a][b][m][n] = (AccV){0, 0, 0, 0};
    bf16x8 At[4][2], B0[2][2], B1[2][2];
    const char* cA = (const char*)g.A + (size_t)cur.pm * tA; const char* cB = (const char*)g.Bt + (size_t)cur.pn * tB;
    S.a_ready(cur);
    PG8_STAGE(PG8_SB(0, 0), cB, voffB); PG8_STAGE(PG8_SA(0, 0), cA, voffA); PG8_STAGE(PG8_SB(0, 1), cB + hB, voffB); PG8_STAGE(PG8_SA(0, 1), cA + hA, voffA);
    if (wr == 1) PG8_BAR;
    PG8_WAIT_V(4); PG8_BAR;
    PG8_STAGE(PG8_SB(1, 0), cB + kstep, voffB); PG8_STAGE(PG8_SA(1, 0), cA + kstep, voffA); PG8_STAGE(PG8_SB(1, 1), cB + hB + kstep, voffB);
    PG8_WAIT_V(6); PG8_BAR;
    for (;;) {
        const bool has_next = S.next(ui + 1, nxt);
        const char* nA = has_next ? (const char*)g.A + (size_t)nxt.pm * tA : cA; const char* nB = has_next ? (const char*)g.Bt + (size_t)nxt.pn * tB : cB;
        for (int t = 0; t < nt; t += 2) {
            const bool last = (t == nt - 2);
            const char* a1 = cA + (size_t)(t + 1) * kstep;
            const char* a2 = last ? nA : cA + (size_t)(t + 2) * kstep; const char* b2 = last ? nB : cB + (size_t)(t + 2) * kstep;
            const char* a3 = a2 + kstep; const char* b3 = b2 + kstep;
            if (last && has_next) S.a_ready(nxt);
            PG8_LDB(B0, 0, 0); PG8_SCHED; PG8_LDA(At, 0, 0); PG8_STAGE(PG8_SA(1, 1), a1 + hA, voffA);
            PG8_WAIT_L(8); PG8_BAR; PG8_WAIT_L(0); PG8_MMA(0, 0, At, B0); PG8_BAR; PG8_SCHED;
            PG8_LDB(B1, 0, 1); PG8_STAGE(PG8_SB(0, 0), b2, voffB);
            PG8_BAR; PG8_WAIT_L(0); PG8_MMA(0, 1, At, B1); PG8_BAR;
            PG8_LDA(At, 0, 1); PG8_STAGE(PG8_SA(0, 0), a2, voffA);
            PG8_BAR; PG8_WAIT_L(0); PG8_MMA(1, 0, At, B0); PG8_BAR; PG8_SCHED;
            PG8_STAGE(PG8_SB(0, 1), b2 + hB, voffB);
            PG8_WAIT_V(6); PG8_BAR; PG8_MMA(1, 1, At, B1); PG8_BAR;
            PG8_LDB(B0, 1, 0); PG8_SCHED; PG8_LDA(At, 1, 0); PG8_STAGE(PG8_SA(0, 1), a2 + hA, voffA);
            PG8_WAIT_L(8); PG8_BAR; PG8_WAIT_L(0); PG8_MMA(0, 0, At, B0); PG8_BAR; PG8_SCHED;
            PG8_LDB(B1, 1, 1); PG8_STAGE(PG8_SB(1, 0), b3, voffB);
            PG8_BAR; PG8_WAIT_L(0); PG8_MMA(0, 1, At, B1); PG8_BAR;
            PG8_LDA(At, 1, 1); PG8_STAGE(PG8_SA(1, 0), a3, voffA);
            PG8_BAR; PG8_WAIT_L(0); PG8_MMA(1, 0, At, B0); PG8_BAR; PG8_SCHED;
            PG8_STAGE(PG8_SB(1, 1), b3 + hB, voffB);
            PG8_WAIT_V(6); PG8_BAR; PG8_MMA(1, 1, At, B1); PG8_BAR;
        }
        cur.ord = ui; E(acc, cur, wr, wc, fr, fq); S.done(cur);
        if (!has_next) break;
#pragma unroll
        for (int a = 0; a < 2; ++a)
#pragma unroll
            for (int b = 0; b < 2; ++b)
#pragma unroll
                for (int m = 0; m < 4; ++m)
#pragma unroll
                    for (int n = 0; n < 2; ++n) acc[a][b][m][n] = (AccV){0, 0, 0, 0};
        cur = nxt; cA = nA; cB = nB; ++ui;
    }
    PG8_WAIT_V(0);
    if (wr == 0) PG8_BAR;
    PG8_BAR;
#undef PG8_SA
#undef PG8_SB
#undef PG8_STAGE
#undef PG8_LDA
#undef PG8_LDB
#undef PG8_MMA
#undef PG8_WAIT_V
#undef PG8_WAIT_L
#undef PG8_BAR
#undef PG8_SCHED
}
}

typedef f32x4 AccT[2][2][4][2];
typedef i32x4 AccI[2][2][4][2];
#define EPI_LOOP_ROWS for (int ai = 0; ai < 2; ++ai) _Pragma("unroll") for (int m = 0; m < 4; ++m)

__device__ __forceinline__ void scale16(float (&v)[16], const AccI& acc, int ai, int m, const f32x4 (&cv)[4], float rsc) {
#pragma unroll
    for (int bj = 0; bj < 2; ++bj)
#pragma unroll
        for (int n = 0; n < 2; ++n)
#pragma unroll
            for (int e = 0; e < 4; ++e) v[8 * bj + 4 * n + e] = (float)acc[ai][bj][m][n][e] * cv[2 * bj + n][e] * rsc;
}
constexpr int SCL_OFF = RING_BYTES, SCL_UNIT = 2048;
static_assert(SCL_OFF + 4 * SCL_UNIT <= MISC_OFF, "scale tables");
template <class Sched>
__device__ __forceinline__ bool stage_scales(LAS unsigned char* lds, int wave, int lane, const Sched& S, const float* rs, const float* cs) {
    pg8::Unit u;
    if (S.next(4, u)) return false;
#pragma unroll
    for (int i = 0; i < 4; ++i) {
        if (!S.next(i, u)) break;
        const float* src = wave < 4 ? rs + u.pm * 256 + wave * 64 : cs + u.pn * 256 + (wave - 4) * 64;
        __builtin_amdgcn_global_load_lds((const unsigned*)(src + lane), (LAS unsigned*)(lds + SCL_OFF + i * SCL_UNIT + wave * 256), 4, 0, 0);
    }
    return true;
}
#define EPI_SCALES_DECL constexpr bool lsc = LSC; const LAS float* sl_ = (const LAS float*)(size_t)(SCL_OFF + u.ord * SCL_UNIT); f32x4 cv[4]; \
    _Pragma("unroll") for (int q = 0; q < 4; ++q) cv[q] = lsc ? *(const LAS f32x4*)(sl_ + 256 + wc * 64 + 16 * fq + 4 * q) : *(const f32x4*)(cs + c + 4 * q);
#define EPI_ROWSCALE(ai, m, r) (lsc ? sl_[wr * 64 + fr + (ai) * 128 + (m) * 16] : rs[r])
#define EPI_NT_SCALES constexpr bool lsc = LSC; const LAS float* sl_ = (const LAS float*)(size_t)(SCL_OFF + u.ord * SCL_UNIT); \
    const f32x4 cv4 = lsc ? *(const LAS f32x4*)(sl_ + 256 + wc * 64 + 4 * fr) : *(const f32x4*)(cs + c);
#define EPI_NT_ROWSCALES(ai, m) (lsc ? *(const LAS f32x4*)(sl_ + wr * 64 + 4 * fq + (ai) * 128 + (m) * 16) : *(const f32x4*)(rs + rb + (ai) * 128 + (m) * 16))
#define EPI_NT_VALS(v, ai, m, e, rsc) do { v[0] = (float)acc[ai][0][m][0][e] * cv4[0] * (rsc); v[1] = (float)acc[ai][0][m][1][e] * cv4[1] * (rsc); \
    v[2] = (float)acc[ai][1][m][0][e] * cv4[2] * (rsc); v[3] = (float)acc[ai][1][m][1][e] * cv4[3] * (rsc); } while (0)
#define EPI_NT_PACK(w, ai, m, e, rsc) do { float v_[4]; EPI_NT_VALS(v_, ai, m, e, rsc); w.x = pk2(v_[0], v_[1]); w.y = pk2(v_[2], v_[3]); } while (0)
__device__ __forceinline__ void epi_pair(const u32x2 (&w)[4], u32x4 (&o)[2], bool odd) {
#pragma unroll
    for (int k = 0; k < 2; ++k) {
        const unsigned kx = odd ? w[2 * k + 1].x : w[2 * k].x, ky = odd ? w[2 * k + 1].y : w[2 * k].y;
        const unsigned sx = odd ? w[2 * k].x : w[2 * k + 1].x, sy = odd ? w[2 * k].y : w[2 * k + 1].y;
        const unsigned rx = (unsigned)__builtin_amdgcn_update_dpp(0, (int)sx, 0xB1, 0xf, 0xf, false), ry = (unsigned)__builtin_amdgcn_update_dpp(0, (int)sy, 0xB1, 0xf, 0xf, false);
        o[k].x = odd ? rx : kx; o[k].y = odd ? ry : ky; o[k].z = odd ? kx : rx; o[k].w = odd ? ky : ry;
    }
}
template <bool LSC>
struct EpiQKVU {
    static constexpr int PERM = 3; static constexpr bool I8 = true, NT = true;
    bf16_t *Q, *Kp, *V, *UX; const float *rs, *cs;
    __device__ __forceinline__ void operator()(const AccI& acc, const pg8::Unit& u, int wr, int wc, int fr, int fq) const {
        const int rb = u.pm * 256 + wr * 64 + 4 * fq, c = u.pn * 256 + wc * 64 + 4 * fr;
        const bool odd = fr & 1; const int cp = u.pn * 256 + wc * 64 + 4 * (fr & ~1);
        EPI_NT_SCALES
        static_assert(WS_K - WS_Q == WS_V - WS_K, "q, k, v equally spaced");
        bf16_t* qkv = Q + (size_t)(u.pn >> 1) * ((WS_K - WS_Q) / 2) + (u.pn & 1) * 256 + wc * 64 + 4 * (fr & ~1);
        const int g = (cp - 1536) >> 4, ch = (cp - 1536) & 15;
#pragma unroll
        EPI_LOOP_ROWS {
            const f32x4 rv = EPI_NT_ROWSCALES(ai, m);
            u32x2 w[4]; u32x4 o[2];
#pragma unroll
            for (int e = 0; e < 4; ++e) EPI_NT_PACK(w[e], ai, m, e, rv[e]);
            epi_pair(w, o, odd);
#pragma unroll
            for (int k = 0; k < 2; ++k) {
                const int r = rb + ai * 128 + m * 16 + 2 * k + (odd ? 1 : 0);
                bf16_t* dst = u.pn < 6 ? qkv + (size_t)r * AW : UX + ((size_t)(g * ROWS_G + (r >> 5)) * K2 + (r & 31) * SC + ch);
                *(u32x4*)dst = o[k];
            }
        }
    }
};
struct EpiE {
    static constexpr int PERM = 3; static constexpr bool I8 = false, NT = true;
    float* E;
    __device__ __forceinline__ void operator()(const AccT& acc, const pg8::Unit& u, int wr, int wc, int fr, int fq) const {
        const int rb = u.pm * 256 + wr * 64 + 4 * fq, col0 = wc * 64 + 4 * fr;
#pragma unroll
        EPI_LOOP_ROWS {
#pragma unroll
            for (int e = 0; e < 4; ++e)
                *(f32x4*)(E + (size_t)(rb + ai * 128 + m * 16 + e) * N1 + col0) = (f32x4){acc[ai][0][m][0][e], acc[ai][0][m][1][e], acc[ai][1][m][0][e], acc[ai][1][m][1][e]};
        }
    }
};
struct EpiY {
    static constexpr int PERM = 3; static constexpr bool I8 = false, NT = true;
    bf16_t* Y;
    __device__ __forceinline__ void operator()(const AccT& acc, const pg8::Unit& u, int wr, int wc, int fr, int fq) const {
        const int g = u.pn >> 1; const bool odd = fr & 1;
        const int rgb = (u.pm & 3) * 256 + wr * 64 + 4 * fq, nc = (u.pn & 1) * 256 + wc * 64 + 4 * (fr & ~1), i = nc >> 4, c0 = nc & 15;
#pragma unroll
        EPI_LOOP_ROWS {
            u32x2 w[4]; u32x4 o[2];
#pragma unroll
            for (int e = 0; e < 4; ++e) { w[e].x = pk2(gelu1(acc[ai][0][m][0][e]), gelu1(acc[ai][0][m][1][e])); w[e].y = pk2(gelu1(acc[ai][1][m][0][e]), gelu1(acc[ai][1][m][1][e])); }
            epi_pair(w, o, odd);
#pragma unroll
            for (int k = 0; k < 2; ++k) {
                const int rg = rgb + ai * 128 + m * 16 + 2 * k + (odd ? 1 : 0);
                *(u32x4*)(Y + ((size_t)rg * CL + i) * SW + g * SC + c0) = o[k];
            }
        }
    }
};
struct EpiGLU {
    static constexpr int PERM = 4; static constexpr bool I8 = false, NT = true;
    bf16_t* O;
    __device__ __forceinline__ void operator()(const AccT& acc, const pg8::Unit& u, int wr, int wc, int fr, int fq) const {
        const int rb = u.pm * 256 + wr * 64 + 4 * fq, j0 = u.pn * 128 + wc * 32 + 2 * fr;
#pragma unroll
        EPI_LOOP_ROWS {
#pragma unroll
            for (int e = 0; e < 4; ++e) {
                const float o0 = acc[ai][0][m][0][e] * __builtin_amdgcn_rcpf(1.f + __builtin_amdgcn_exp2f(-LOG2E * acc[ai][1][m][0][e]));
                const float o1 = acc[ai][0][m][1][e] * __builtin_amdgcn_rcpf(1.f + __builtin_amdgcn_exp2f(-LOG2E * acc[ai][1][m][1][e]));
                *(unsigned*)(O + (size_t)(rb + ai * 128 + m * 16 + e) * SW + j0) = pk2(o0, o1);
            }
        }
    }
};
template <bool LSC>
struct EpiRes {
    static constexpr int PERM = 3; static constexpr bool I8 = true, NT = true;
    bf16_t* X; const float *rs, *cs; bool store;
    __device__ __forceinline__ void operator()(const AccI& acc, const pg8::Unit& u, int wr, int wc, int fr, int fq) const {
        const int rb = u.pm * 256 + wr * 64 + 4 * fq, c = u.pn * 256 + wc * 64 + 4 * fr;
        const bool odd = fr & 1; const int cp = u.pn * 256 + wc * 64 + 4 * (fr & ~1);
        if (!store) {
#pragma unroll
            for (int ai = 0; ai < 2; ++ai)
#pragma unroll
                for (int bj = 0; bj < 2; ++bj)
#pragma unroll
                    for (int m = 0; m < 4; ++m)
#pragma unroll
                        for (int n = 0; n < 2; ++n) asm volatile("" :: "v"(acc[ai][bj][m][n]));
            return;
        }
        EPI_NT_SCALES
        u32x4 sx[2][4][2];
#pragma unroll
        EPI_LOOP_ROWS { const bf16_t* xq = X + (size_t)(rb + ai * 128 + m * 16 + (odd ? 1 : 0)) * DM + cp; sx[ai][m][0] = *(const u32x4*)xq; sx[ai][m][1] = *(const u32x4*)(xq + 2 * DM); }
        __builtin_amdgcn_sched_barrier(0);
#pragma unroll
        EPI_LOOP_ROWS {
            const f32x4 rv = EPI_NT_ROWSCALES(ai, m);
            bf16_t* xp = X + (size_t)(rb + ai * 128 + m * 16 + (odd ? 1 : 0)) * DM + cp;
            const u32x4 s0 = sx[ai][m][0], s1 = sx[ai][m][1];
            u32x2 w[4]; u32x4 d[2];
#pragma unroll
            for (int e = 0; e < 4; ++e) EPI_NT_PACK(w[e], ai, m, e, rv[e]);
            epi_pair(w, d, odd);
            u32x4 o0, o1;
#pragma unroll
            for (int k = 0; k < 4; ++k) { o0[k] = pk2(bflo(s0[k]) + bflo(d[0][k]), bfhi(s0[k]) + bfhi(d[0][k])); o1[k] = pk2(bflo(s1[k]) + bflo(d[1][k]), bfhi(s1[k]) + bfhi(d[1][k])); }
            *(u32x4*)xp = o0; *(u32x4*)(xp + 2 * DM) = o1;
        }
    }
};
template <bool LSC>
struct EpiResF {
    static constexpr int PERM = 3; static constexpr bool I8 = true, NT = true;
    const float* Xin; bf16_t* X; const float *rs, *cs;
    __device__ __forceinline__ void operator()(const AccI& acc, const pg8::Unit& u, int wr, int wc, int fr, int fq) const {
        const int rb = u.pm * 256 + wr * 64 + 4 * fq, c = u.pn * 256 + wc * 64 + 4 * fr;
        const bool odd = fr & 1; const int cp = u.pn * 256 + wc * 64 + 4 * (fr & ~1);
        EPI_NT_SCALES
#pragma unroll
        for (int ai = 0; ai < 2; ++ai) {
            f32x4 sx[4][2][2];
#pragma unroll
            for (int m = 0; m < 4; ++m)
#pragma unroll
                for (int k = 0; k < 2; ++k) { const float* xq = Xin + (size_t)(rb + ai * 128 + m * 16 + 2 * k + (odd ? 1 : 0)) * DM + cp; sx[m][k][0] = *(const f32x4*)xq; sx[m][k][1] = *(const f32x4*)(xq + 4); }
            __builtin_amdgcn_sched_barrier(0);
#pragma unroll
            for (int m = 0; m < 4; ++m) {
                const f32x4 rv = EPI_NT_ROWSCALES(ai, m);
                u32x2 w[4]; u32x4 d[2];
#pragma unroll
                for (int e = 0; e < 4; ++e) EPI_NT_PACK(w[e], ai, m, e, rv[e]);
                epi_pair(w, d, odd);
#pragma unroll
                for (int k = 0; k < 2; ++k) {
                    const f32x4 a0 = sx[m][k][0], a1 = sx[m][k][1];
                    u32x4 o; o.x = pk2(a0.x + bflo(d[k].x), a0.y + bfhi(d[k].x)); o.y = pk2(a0.z + bflo(d[k].y), a0.w + bfhi(d[k].y));
                    o.z = pk2(a1.x + bflo(d[k].z), a1.y + bfhi(d[k].z)); o.w = pk2(a1.z + bflo(d[k].w), a1.w + bfhi(d[k].w));
                    *(u32x4*)(X + (size_t)(rb + ai * 128 + m * 16 + 2 * k + (odd ? 1 : 0)) * DM + cp) = o;
                }
            }
        }
    }
};
template <bool LSC>
struct EpiBf {
    static constexpr int PERM = 3; static constexpr bool I8 = true, NT = true;
    bf16_t* O; int ldc; const float *rs, *cs;
    __device__ __forceinline__ void operator()(const AccI& acc, const pg8::Unit& u, int wr, int wc, int fr, int fq) const {
        const int rb = u.pm * 256 + wr * 64 + 4 * fq, c = u.pn * 256 + wc * 64 + 4 * fr;
        const bool odd = fr & 1; const int cp = u.pn * 256 + wc * 64 + 4 * (fr & ~1);
        EPI_NT_SCALES
#pragma unroll
        EPI_LOOP_ROWS {
            const f32x4 rv = EPI_NT_ROWSCALES(ai, m);
            u32x2 w[4]; u32x4 o[2];
#pragma unroll
            for (int e = 0; e < 4; ++e) EPI_NT_PACK(w[e], ai, m, e, rv[e]);
            epi_pair(w, o, odd);
#pragma unroll
            for (int k = 0; k < 2; ++k) *(u32x4*)(O + (size_t)(rb + ai * 128 + m * 16 + 2 * k + (odd ? 1 : 0)) * ldc + cp) = o[k];
        }
    }
};

struct Args {
    const float* in[22];
    float* out;
    unsigned char* ws;
    int ph_lo, ph_hi;
    signed char bkt[3][132];
    int pad;
};
static_assert(sizeof(Args) % 8 == 0, "Args size");

struct Ctx {
    LAS unsigned char* lds;
    unsigned char* ws;
    int tid, lane, wave, G, bid;
};
#define MKCTX(F, a) Ctx F; { int _t = wv * 64 + lane_id(); asm volatile("" : "+v"(_t)); size_t _z = 0; asm volatile("" : "+s"(_z)); \
    F.lds = (LAS unsigned char*)lds_raw; F.ws = (a).ws + _z; F.tid = _t; F.lane = _t & 63; F.wave = __builtin_amdgcn_readfirstlane(_t >> 6); F.G = gridDim.x; F.bid = blockIdx.x; }

template <class RowMap>
__device__ __forceinline__ void transpose_item(const float* W, int K, int N, bf16_t* WT, const RowMap& rm, LAS float* scr, int item, int lane) {
    const int nblk = N / 32, kb = item / nblk, nb = item % nblk, k0 = 64 * kb, n0 = 32 * nb;
    float rr[32];
#pragma unroll
    for (int i = 0; i < 32; ++i) rr[i] = W[(size_t)(k0 + 2 * i + (lane >> 5)) * N + n0 + (lane & 31)];
#pragma unroll
    for (int i = 0; i < 32; ++i) scr[(2 * i + (lane >> 5)) * 33 + (lane & 31)] = rr[i];
    asm volatile("s_waitcnt lgkmcnt(0)" ::: "memory");
    const int c = lane & 7;
#pragma unroll
    for (int j = 0; j < 4; ++j) { const int n = (lane >> 3) + 8 * j; const LAS float* s = scr + (8 * c) * 33 + n;
        u32x4 o; o.x = pk2(s[0 * 33], s[1 * 33]); o.y = pk2(s[2 * 33], s[3 * 33]); o.z = pk2(s[4 * 33], s[5 * 33]); o.w = pk2(s[6 * 33], s[7 * 33]);
        *(u32x4*)(WT + (size_t)rm(n0 + n) * K + k0 + 8 * c) = o; }
    asm volatile("s_waitcnt lgkmcnt(0)" ::: "memory");
}
struct RowGlu { __device__ __forceinline__ int operator()(int n) const { const int j = n < SW ? n : n - SW; return (j >> 7) * 256 + (j & 127) + (n < SW ? 0 : 128); } };

__device__ __forceinline__ void ssm_build_unit(const Ctx& F, const Args& a, int l, int g, int s) {
    LAS f32x2* LP = (LAS f32x2*)F.lds;
    LAS f32x2* BB = (LAS f32x2*)(F.lds + 33792);
    LAS float* KT = (LAS float*)(F.lds + 33792 + 16384);
    LAS f32x2* CQ = (LAS f32x2*)(F.lds + 33792 + 16384 + 16384);
    const float* lam_re = a.in[8]; const float* lam_im = a.in[9]; const float* log_step = a.in[10];
    const float* b_re = a.in[11]; const float* b_im = a.in[12]; const float* c_re = a.in[13]; const float* c_im = a.in[14]; const float* d_skip = a.in[15];
    __syncthreads();
    for (int e = F.tid; e < 2 * 33 * 64; e += NTHREADS) {
        const int dir = e / (33 * 64), tau = (e / 64) % 33, p = e % 64;
        const int pi = ((l * 2 + dir) * SG + g) * SP + p;
        const float st = expf(log_step[(l * 2 + dir) * SG + g]) * (float)tau;
        const float mag = expf(lam_re[pi] * st);
        float sn, cs; sincosf(lam_im[pi] * st, &sn, &cs);
        const f32x2 v = (f32x2){mag * cs, mag * sn};
        LP[e] = v;
        if (tau == 32 && s == 0) ((f32x2*)(F.ws + WS_LAML))[pi] = v;
    }
    {
        const int dp = F.tid & 127, dir = dp >> 6, p = dp & 63, c0 = (F.tid >> 7) * 4;
        const int pi = ((l * 2 + dir) * SG + g) * SP + p;
        const double st = exp((double)log_step[(l * 2 + dir) * SG + g]);
        const double lr = lam_re[pi], li = lam_im[pi];
        double sn, cs; sincos(li * st, &sn, &cs);
        const double mag = exp(lr * st), br = mag * cs - 1.0, bi = mag * sn;
        const double den = lr * lr + li * li;
        const double fr = (br * lr + bi * li) / den, fi = (bi * lr - br * li) / den;
#pragma unroll
        for (int k = 0; k < 4; ++k) {
            const double xr = b_re[(size_t)pi * SC + c0 + k], xi = b_im[(size_t)pi * SC + c0 + k];
            BB[dp * 16 + c0 + k] = (f32x2){(float)(fr * xr - fi * xi), (float)(fr * xi + fi * xr)};
        }
    }
    { const int dir = F.tid >> 8, cq = (F.tid >> 6) & 3, p = F.tid & 63;
      const size_t ci = ((size_t)((l * 2 + dir) * SG + g) * SC + 4 * s + cq) * SP + p;
      CQ[F.tid] = (f32x2){c_re[ci], c_im[ci]}; }
    __syncthreads();
    {
        const int to = F.tid >> 7, dir = (F.tid >> 6) & 1, cq = (F.tid >> 4) & 3, c2 = F.tid & 15;
        float acc[8];
#pragma unroll
        for (int t8 = 0; t8 < 8; ++t8) acc[t8] = 0.f;
        const LAS f32x4* cqp = (const LAS f32x4*)(CQ + (dir * 4 + cq) * 64);
        const LAS f32x2* bbp = BB + (dir * 64) * 16 + c2;
        const LAS f32x4* lpp = (const LAS f32x4*)(LP + (dir * 33 + 8 * to) * 64);
#pragma unroll 2
        for (int p2 = 0; p2 < SP / 2; ++p2) {
            const f32x4 cc = cqp[p2];
            const f32x2 b0 = bbp[(2 * p2) * 16], b1 = bbp[(2 * p2 + 1) * 16];
            const float zr0 = cc.x * b0.x - cc.y * b0.y, zi0 = cc.x * b0.y + cc.y * b0.x;
            const float zr1 = cc.z * b1.x - cc.w * b1.y, zi1 = cc.z * b1.y + cc.w * b1.x;
#pragma unroll
            for (int t8 = 0; t8 < 8; ++t8) { const f32x4 lp = lpp[t8 * 32 + p2]; acc[t8] += (zr0 * lp.x - zi0 * lp.y) + (zr1 * lp.z - zi1 * lp.w); }
        }
#pragma unroll
        for (int t8 = 0; t8 < 8; ++t8) KT[((dir * 32 + 8 * to + t8) * 4 + cq) * 16 + c2] = acc[t8];
    }
    __syncthreads();
    bf16_t* M2 = (bf16_t*)(F.ws + WS_M2) + (size_t)(l * SG + g) * N2 * K2;
    { const int k = F.tid, j = k >> 4, c2 = k & 15;
      const float dk = d_skip[l * SW + g * SC + c2];
      for (int r = 0; r < 128; ++r) {
          const int i = r >> 2, cq = r & 3, c = 4 * s + cq;
          float v = 0.f;
          if (j <= i) v += KT[((0 * 32 + (i - j)) * 4 + cq) * 16 + c2];
          if (j >= i) v += KT[((1 * 32 + (j - i)) * 4 + cq) * 16 + c2];
          if (j == i && c == c2) v += dk;
          M2[(size_t)(i * SC + c) * K2 + k] = (bf16_t)f2bf(v);
      } }
    if (F.tid < 256) {
        const int kk = F.tid, dir = kk >> 7, im = (kk >> 6) & 1, p = kk & 63;
        for (int r = 0; r < 128; ++r) {
            const int i = r >> 2, cq = r & 3, c = 4 * s + cq;
            const f32x2 cc = CQ[(dir * 4 + cq) * 64 + p];
            const int tau = dir == 0 ? i + 1 : CL - i;
            const f32x2 lp = LP[(dir * 33 + tau) * 64 + p];
            const float v = im ? -(cc.x * lp.y + cc.y * lp.x) : (cc.x * lp.x - cc.y * lp.y);
            M2[(size_t)(i * SC + c) * K2 + K1 + kk] = (bf16_t)f2bf(v);
        }
    }
    bf16_t* W1 = (bf16_t*)(F.ws + WS_W1) + (size_t)(l * SG + g) * N1 * K1;
    { const int k = F.tid, j = k >> 4, c2 = k & 15;
      for (int rr = 0; rr < 64; ++rr) {
          const int n = 64 * s + rr, dir = n >> 7, im = (n >> 6) & 1, p = n & 63;
          const int tau = dir == 0 ? CL - 1 - j : j;
          const f32x2 lp = LP[(dir * 33 + tau) * 64 + p], bb = BB[(dir * 64 + p) * 16 + c2];
          const float v = im ? (lp.x * bb.y + lp.y * bb.x) : (lp.x * bb.x - lp.y * bb.y);
          W1[(size_t)n * K1 + k] = (bf16_t)f2bf(v);
      } }
    __syncthreads();
}

__device__ __forceinline__ float wave_max(float v);
__device__ __forceinline__ unsigned pk4_i8(float a, float b, float c, float d);
struct TrI8 { float r[32]; float mx[2]; };
__device__ __forceinline__ void tr_i8_load(TrI8& T, const float* W, int N, const unsigned* cmaxbits, int item, int lane) {
    const int nblk = N / 32, kb = item / nblk, nb = item % nblk, k0 = 64 * kb, n0 = 32 * nb;
#pragma unroll
    for (int i = 0; i < 32; ++i) T.r[i] = W[(size_t)(k0 + 2 * i + (lane >> 5)) * N + n0 + (lane & 31)];
#pragma unroll
    for (int j = 0; j < 2; ++j) { const unsigned b = cmaxbits[n0 + (lane >> 2) + 16 * j]; T.mx[j] = __builtin_bit_cast(float, b); }
}
__device__ __forceinline__ void tr_i8_finish(const TrI8& T, int K, int N, unsigned char* WT, float* wsc, LAS float* scr, int item, int lane) {
    const int nblk = N / 32, kb = item / nblk, nb = item % nblk, k0 = 64 * kb, n0 = 32 * nb;
#pragma unroll
    for (int i = 0; i < 32; ++i) scr[(2 * i + (lane >> 5)) * 33 + (lane & 31)] = T.r[i];
    asm volatile("s_waitcnt lgkmcnt(0)" ::: "memory");
    const int c = lane & 3;
#pragma unroll
    for (int j = 0; j < 2; ++j) { const int n = (lane >> 2) + 16 * j; const LAS float* s = scr + (16 * c) * 33 + n;
        const float mx = T.mx[j];
        const float sc = mx > 0.f ? mx * (1.f / 127.f) : 1.f, is = 1.f / sc;
        u32x4 o; o.x = pk4_i8(s[0 * 33] * is, s[1 * 33] * is, s[2 * 33] * is, s[3 * 33] * is); o.y = pk4_i8(s[4 * 33] * is, s[5 * 33] * is, s[6 * 33] * is, s[7 * 33] * is);
        o.z = pk4_i8(s[8 * 33] * is, s[9 * 33] * is, s[10 * 33] * is, s[11 * 33] * is); o.w = pk4_i8(s[12 * 33] * is, s[13 * 33] * is, s[14 * 33] * is, s[15 * 33] * is);
        *(u32x4*)(WT + (size_t)(n0 + n) * K + k0 + 16 * c) = o;
        if (kb == 0 && c == 0) wsc[n0 + n] = sc; }
    asm volatile("s_waitcnt lgkmcnt(0)" ::: "memory");
}
__device__ __forceinline__ const float* i8w_src(const Args& a, int mi, int& N, int& coff) {
    if (mi < 2) { N = 2048; coff = WSC_IN + mi * 2048; return a.in[1] + (size_t)mi * DM * 2048; }
    if (mi < 4) { N = DM; coff = WSC_OUT + (mi - 2) * DM; return a.in[2] + (size_t)(mi - 2) * DM * DM; }
    N = DM; coff = WSC_Q + (mi - 4) * DM; return a.in[17] + (size_t)(mi - 4) * DM * DM;
}
template <int NR>
__device__ __forceinline__ void rms_rows_to_i8(const float* xrow, const float* g, unsigned char* qrow, float* qscale, bf16_t* xcopy, int lane) {
    f32x4 v[NR][4];
#pragma unroll
    for (int r = 0; r < NR; ++r)
#pragma unroll
        for (int j = 0; j < 4; ++j) v[r][j] = *((const f32x4*)(xrow + (size_t)r * DM) + lane + 64 * j);
    f32x4 gg[4];
#pragma unroll
    for (int j = 0; j < 4; ++j) gg[j] = *((const f32x4*)g + lane + 64 * j);
#pragma unroll
    for (int r = 0; r < NR; ++r) {
        float s = 0.f;
#pragma unroll
        for (int j = 0; j < 4; ++j) s += (v[r][j].x * v[r][j].x + v[r][j].y * v[r][j].y) + (v[r][j].z * v[r][j].z + v[r][j].w * v[r][j].w);
        if (xcopy) {
#pragma unroll
            for (int j = 0; j < 4; ++j) { u32x2 w; w.x = pk2(v[r][j].x, v[r][j].y); w.y = pk2(v[r][j].z, v[r][j].w); *((u32x2*)(xcopy + (size_t)r * DM) + lane + 64 * j) = w; }
        }
        const float inv = rsqrtf(wave_sum(s) * (1.f / DM) + EPS);
        float mx = 0.f;
#pragma unroll
        for (int j = 0; j < 4; ++j) { v[r][j] = (f32x4){v[r][j].x * inv * gg[j].x, v[r][j].y * inv * gg[j].y, v[r][j].z * inv * gg[j].z, v[r][j].w * inv * gg[j].w};
            mx = fmaxf(mx, fmaxf(fmaxf(fabsf(v[r][j].x), fabsf(v[r][j].y)), fmaxf(fabsf(v[r][j].z), fabsf(v[r][j].w)))); }
        mx = wave_max(mx);
        const float sc = mx > 0.f ? mx * (1.f / 127.f) : 1.f, is = 1.f / sc;
        unsigned* q4 = (unsigned*)(qrow + (size_t)r * DM) + lane;
#pragma unroll
        for (int j = 0; j < 4; ++j) q4[64 * j] = pk4_i8(v[r][j].x * is, v[r][j].y * is, v[r][j].z * is, v[r][j].w * is);
        if (lane == 0) qscale[r] = sc;
    }
}
template <int NR, bool NT>
__device__ __forceinline__ void load_xb_rows(float (&v)[NR][16], const bf16_t* xrow, int lane) {
    u32x4 w[NR][2];
#pragma unroll
    for (int r = 0; r < NR; ++r)
#pragma unroll
        for (int q = 0; q < 2; ++q) { const u32x4* p = (const u32x4*)(xrow + (size_t)r * DM + 512 * q + 8 * lane); w[r][q] = NT ? __builtin_nontemporal_load(p) : *p; }
#pragma unroll
    for (int r = 0; r < NR; ++r)
#pragma unroll
        for (int q = 0; q < 2; ++q)
#pragma unroll
            for (int k = 0; k < 4; ++k) { v[r][8 * q + 2 * k] = bflo(w[r][q][k]); v[r][8 * q + 2 * k + 1] = bfhi(w[r][q][k]); }
}
__device__ __forceinline__ void rms_inplace16(float (&v)[16], const float* g, int lane) {
    float s = 0.f;
#pragma unroll
    for (int k = 0; k < 16; ++k) s += v[k] * v[k];
    const float inv = rsqrtf(wave_sum(s) * (1.f / DM) + EPS);
#pragma unroll
    for (int q = 0; q < 2; ++q) { const f32x4 g0 = *(const f32x4*)(g + 512 * q + 8 * lane), g1 = *(const f32x4*)(g + 512 * q + 8 * lane + 4);
#pragma unroll
        for (int k = 0; k < 4; ++k) { v[8 * q + k] *= inv * g0[k]; v[8 * q + 4 + k] *= inv * g1[k]; } }
}
__device__ __forceinline__ void store_i8_row16(const float (&v)[16], unsigned char* qrow, float* qscale, int lane) {
    float mx = 0.f;
#pragma unroll
    for (int k = 0; k < 16; ++k) mx = fmaxf(mx, fabsf(v[k]));
    mx = wave_max(mx);
    const float sc = mx > 0.f ? mx * (1.f / 127.f) : 1.f, is = 1.f / sc;
#pragma unroll
    for (int q = 0; q < 2; ++q) { u32x2 w; w.x = pk4_i8(v[8 * q] * is, v[8 * q + 1] * is, v[8 * q + 2] * is, v[8 * q + 3] * is); w.y = pk4_i8(v[8 * q + 4] * is, v[8 * q + 5] * is, v[8 * q + 6] * is, v[8 * q + 7] * is);
        *(u32x2*)(qrow + 512 * q + 8 * lane) = w; }
    if (lane == 0) *qscale = sc;
}
template <int NR>
__device__ __forceinline__ void rms_xb_rows_to_i8(const bf16_t* xrow, const float* g, unsigned char* qrow, float* qscale, int lane) {
    float v[NR][16];
    load_xb_rows<NR, false>(v, xrow, lane);
#pragma unroll
    for (int r = 0; r < NR; ++r) { rms_inplace16(v[r], g, lane); store_i8_row16(v[r], qrow + (size_t)r * DM, qscale + r, lane); }
}
__device__ __forceinline__ void convert_experts(const Ctx& F, const Args& a, int l);
#ifndef PROBE_P0
#define PROBE_P0 0
#endif
__device__ __forceinline__ void p0a_stream(const Ctx& F, const Args& a, const int SK) {
    const int gw = F.bid * NWAVES + F.wave, NGW = F.G * NWAVES;
    if (!(SK & 2)) { unsigned* wmax = (unsigned*)(F.ws + WS_WMAX);
      for (int t = gw; t < 32 * 64; t += NGW) {
          const int cg = t >> 6, seg = t & 63; int mi, cbase;
          if (cg < 16) { mi = cg >> 3; cbase = (cg & 7) * 256; } else if (cg < 24) { mi = 2 + ((cg - 16) >> 2); cbase = ((cg - 16) & 3) * 256; } else { mi = 4 + ((cg - 24) >> 2); cbase = ((cg - 24) & 3) * 256; }
          int N, coff; const float* W = i8w_src(a, mi, N, coff);
          f32x4 v[16];
#pragma unroll
          for (int k = 0; k < 16; ++k) v[k] = *(const f32x4*)(W + (size_t)(seg * 16 + k) * N + cbase + 4 * F.lane);
          f32x4 mx = (f32x4){0.f, 0.f, 0.f, 0.f};
#pragma unroll
          for (int k = 0; k < 16; ++k) { mx.x = fmaxf(mx.x, fabsf(v[k].x)); mx.y = fmaxf(mx.y, fabsf(v[k].y)); mx.z = fmaxf(mx.z, fabsf(v[k].z)); mx.w = fmaxf(mx.w, fabsf(v[k].w)); }
          unsigned* wm = wmax + coff + cbase + 4 * F.lane;
          const float m0 = mx.x, m1 = mx.y, m2 = mx.z, m3 = mx.w;
          atomicMax(wm, __builtin_bit_cast(unsigned, m0)); atomicMax(wm + 1, __builtin_bit_cast(unsigned, m1)); atomicMax(wm + 2, __builtin_bit_cast(unsigned, m2)); atomicMax(wm + 3, __builtin_bit_cast(unsigned, m3));
      } }
    LAS float* scr = (LAS float*)(F.lds + F.wave * 16384);
    constexpr int I_GLU = (SW / 64) * (1024 / 32);
    if (!(SK & 4)) for (int it = gw; it < NLAYER * I_GLU; it += NGW) { const int l = it / I_GLU, r = it % I_GLU;
        transpose_item(a.in[16] + (size_t)l * SW * 1024, SW, 1024, (bf16_t*)(F.ws + WS_WGLU) + (size_t)l * 1024 * SW, RowGlu(), scr, r, F.lane); }
    if (!(SK & 4)) { const float* sk = a.in[18]; bf16_t* o = (bf16_t*)(F.ws + WS_SK); const int n4 = NLAYER * 2 * PH * PKEYS * 64 / 4;
      for (int i = gw * 64 + F.lane; i < n4; i += NGW * 64) { const f32x4 v = ((const f32x4*)sk)[i]; u32x2 w; w.x = pk2(v.x, v.y); w.y = pk2(v.z, v.w); ((u32x2*)o)[i] = w; } }
    if (!(SK & 8)) for (int m = gw * 4; m < TOK; m += NGW * 4) rms_rows_to_i8<4>(a.in[0] + (size_t)m * DM, a.in[6], F.ws + WS_H + (size_t)m * DM, (float*)(F.ws + WS_HSC) + m, gridDim.x == 256 ? (bf16_t*)nullptr : (bf16_t*)(F.ws + WS_XB) + (size_t)m * DM, F.lane);
    if (!(SK & 16) && gridDim.x != 256) convert_experts(F, a, 0);
}
__device__ __forceinline__ void p0a_prologue(const Ctx& F, const Args& a, const int SK) {
    const int cls = F.bid & 3;
    for (int slot = 0; slot < 4; ++slot) {
        if (slot == cls) {
            __syncthreads();
            if (!(SK & 1)) for (int u = F.bid; u < NLAYER * SG * 4; u += F.G) ssm_build_unit(F, a, u >> 7, (u >> 2) & 31, u & 3);
            __syncthreads();
        }
        if (slot < 3) p0a_stream(F, a, SK | (slot == 0 ? (8 | 16) : slot == 1 ? (2 | 4 | 16) : (2 | 4 | 8)));
    }
}
__device__ __forceinline__ void p0b_prologue(const Ctx& F, const Args& a) {
    LAS float* scr = (LAS float*)(F.lds + F.wave * 16384);
    const int gw = F.bid * NWAVES + F.wave, NGW = F.G * NWAVES;
    const unsigned* wmax = (const unsigned*)(F.ws + WS_WMAX); float* wsc = (float*)(F.ws + WS_WSC);
    constexpr int I_IN = (DM / 64) * (2048 / 32), I_SQ = (DM / 64) * (DM / 32), I_ALL = 2 * I_IN + 4 * I_SQ;
    auto locate = [&](int it, int& N, int& coff, int& r, const float*& W, unsigned char*& dst) {
        int mi;
        if (it < 2 * I_IN) { mi = it / I_IN; r = it % I_IN; } else { mi = 2 + (it - 2 * I_IN) / I_SQ; r = (it - 2 * I_IN) % I_SQ; }
        W = i8w_src(a, mi, N, coff);
        dst = mi < 2 ? F.ws + WS_WIN + (size_t)mi * 2048 * DM : mi < 4 ? F.ws + WS_WOUT + (size_t)(mi - 2) * DM * DM : F.ws + WS_WQ + (size_t)(mi - 4) * DM * DM;
    };
    for (int it = gw; it < I_ALL; it += 2 * NGW) {
        const int it2 = it + NGW; const bool two = it2 < I_ALL;
        int N0, c0, r0, N1 = 0, c1 = 0, r1 = 0; const float* W0; const float* W1 = nullptr; unsigned char* d0; unsigned char* d1 = nullptr;
        locate(it, N0, c0, r0, W0, d0);
        TrI8 A, B;
        tr_i8_load(A, W0, N0, wmax + c0, r0, F.lane);
        if (two) { locate(it2, N1, c1, r1, W1, d1); tr_i8_load(B, W1, N1, wmax + c1, r1, F.lane); }
        tr_i8_finish(A, DM, N0, d0, wsc + c0, scr, r0, F.lane);
        if (two) tr_i8_finish(B, DM, N1, d1, wsc + c1, scr, r1, F.lane);
    }
}

__device__ __forceinline__ void p0_main(const Ctx& F, const Args& a) {
    const int cls = F.bid & 3;
    for (int slot = 0; slot < 4; ++slot) {
        if (slot == cls) {
            __syncthreads();
            for (int u = F.bid; u < NLAYER * SG * 4; u += F.G) ssm_build_unit(F, a, u >> 7, (u >> 2) & 31, u & 3);
            __syncthreads();
        }
        if (slot == 0) p0a_stream(F, a, 2 | 8 | 16);
        else if (slot == 1) p0a_stream(F, a, 2 | 4 | 16);
        else if (slot == 2) { p0b_prologue(F, a); p0a_stream(F, a, 2 | 4 | 8); }
    }
}
#define GCH 128
constexpr int GNCH = DM / GCH;
__device__ __forceinline__ float wave_max(float v) {
    v = fmaxf(v, dppf<0xB1>(v)); v = fmaxf(v, dppf<0x4E>(v)); v = fmaxf(v, dppf<0x141>(v)); v = fmaxf(v, dppf<0x140>(v));
    { const unsigned a = __builtin_bit_cast(unsigned, v); const auto r = __builtin_amdgcn_permlane16_swap(a, a, false, false); const unsigned r0 = r[0], r1 = r[1]; v = fmaxf(__builtin_bit_cast(float, r0), __builtin_bit_cast(float, r1)); }
    { const unsigned a = __builtin_bit_cast(unsigned, v); const auto r = __builtin_amdgcn_permlane32_swap(a, a, false, false); const unsigned r0 = r[0], r1 = r[1]; v = fmaxf(__builtin_bit_cast(float, r0), __builtin_bit_cast(float, r1)); }
    return v;
}
__device__ __forceinline__ unsigned pk4_i8(float a, float b, float c, float d) {
    const int ia = (int)rintf(a), ib = (int)rintf(b), ic = (int)rintf(c), id = (int)rintf(d);
    return (unsigned)(ia & 255) | ((unsigned)(ib & 255) << 8) | ((unsigned)(ic & 255) << 16) | ((unsigned)id << 24);
}
template <int NR>
__device__ __forceinline__ void convert_rows_i8(const float* stab, unsigned char* dtab, float* dscale, int e0, int estep, int lane) {
    f32x4 v[NR][4];
#pragma unroll
    for (int r = 0; r < NR; ++r)
#pragma unroll
        for (int j = 0; j < 4; ++j) v[r][j] = *(const f32x4*)(stab + (size_t)(e0 + r * estep) * DM + 16 * lane + 4 * j);
#pragma unroll
    for (int r = 0; r < NR; ++r) {
        const int e = e0 + r * estep;
        float mx = 0.f;
#pragma unroll
        for (int j = 0; j < 4; ++j) mx = fmaxf(mx, fmaxf(fmaxf(fabsf(v[r][j].x), fabsf(v[r][j].y)), fmaxf(fabsf(v[r][j].z), fabsf(v[r][j].w))));
        mx = wave_max(mx);
        const float sc = mx > 0.f ? mx * (1.f / 127.f) : 1.f, is = 1.f / sc;
        u32x4 w;
        w.x = pk4_i8(v[r][0].x * is, v[r][0].y * is, v[r][0].z * is, v[r][0].w * is); w.y = pk4_i8(v[r][1].x * is, v[r][1].y * is, v[r][1].z * is, v[r][1].w * is);
        w.z = pk4_i8(v[r][2].x * is, v[r][2].y * is, v[r][2].z * is, v[r][2].w * is); w.w = pk4_i8(v[r][3].x * is, v[r][3].y * is, v[r][3].z * is, v[r][3].w * is);
        const int d0 = 16 * lane, c = d0 / GCH, off = d0 % GCH;
        *(u32x4*)(dtab + ((size_t)c * NEXP + e) * GCH + off) = w;
        if (lane == 0) dscale[e] = sc;
    }
}
__device__ __forceinline__ void convert_experts(const Ctx& F, const Args& a, int l) {
    const float* su = a.in[19] + (size_t)l * NEXP * DM; const float* sv = a.in[20] + (size_t)l * NEXP * DM;
    unsigned char* du = F.ws + WS_EU; unsigned char* dv = F.ws + WS_EV;
    float* scu = (float*)(F.ws + WS_ESC); float* scv = scu + NEXP;
    const int NGW = F.G * NWAVES;
    for (int e = F.bid * NWAVES + F.wave; e < NEXP; e += 4 * NGW) {
        if (e + 3 * NGW < NEXP) { convert_rows_i8<4>(su, du, scu, e, NGW, F.lane); convert_rows_i8<4>(sv, dv, scv, e, NGW, F.lane); }
        else for (int r = 0; r < 4; ++r) if (e + r * NGW < NEXP) { convert_rows_i8<1>(su, du, scu, e + r * NGW, NGW, F.lane); convert_rows_i8<1>(sv, dv, scv, e + r * NGW, NGW, F.lane); }
    }
}
constexpr int ATT_KT = 0, ATT_VT = 49152, ATT_TAB = 98304, ATT_TABW = 200, ATT_OST = 117504, ATT_OROW = 144;
static_assert(ATT_OST + 8 * 32 * ATT_OROW <= MISC_OFF, "attention LDS map");
__device__ __forceinline__ int crow(int r, int hi) { return (r & 3) + 8 * (r >> 2) + 4 * hi; }
struct AttnUnit { int p, b, h, r, jblk, dsh, Lsub; };
__device__ __forceinline__ AttnUnit attn_decode(int u) {
    AttnUnit U; U.p = u >> 10; const int v = u & 1023, bh = v >> 4, rb = v & 15; U.b = bh >> 3; U.h = bh & 7;
    U.dsh = 2 * U.p; U.Lsub = SEQ >> U.dsh; const int nblk = 16 >> U.dsh; U.r = rb / nblk; U.jblk = (rb % nblk) * 256; return U;
}
template <bool ISV> __device__ __forceinline__ void attn_stage_dma(LAS unsigned char* lds, const bf16_t* src, const AttnUnit& U, int tid, int wave) {
#pragma unroll
    for (int n = 0; n < 6; ++n) {
        const int c = tid + NTHREADS * n, row = c >> 3, pch = c & 7, kp = U.jblk - 64 + row;
        const int ch = ISV ? (pch ^ (((row >> 1) & 1) << 2)) : (pch ^ ((row >> 1) & 7));
        const bool ok = (unsigned)kp < (unsigned)U.Lsub;
        const size_t off = ((size_t)U.b * SEQ + ((size_t)(ok ? kp : 0) << U.dsh) + U.r) * AW + U.h * HD + ch * 8;
        __builtin_amdgcn_global_load_lds((const unsigned*)(src + off), (LAS unsigned*)(lds + (ISV ? ATT_VT : ATT_KT) + (wave * 64 + NTHREADS * n) * 16), 16, 0, 0);
    }
}
template <bool MASK> __device__ __forceinline__ float attn_logits(f32x16 (&acc)[5], const LAS float* tb, int kp0, int Lsub) {
    const float C2 = 0.125f * LOG2E;
    float mx = -3e38f;
#pragma unroll
    for (int kt = 0; kt < 5; ++kt) {
#pragma unroll
        for (int i = 0; i < 16; ++i) {
            const int kr = 32 * kt + (i & 3) + 8 * (i >> 2);
            float x = acc[kt][i] * C2 + tb[kr];
            if (MASK) x = ((unsigned)(kp0 + kr) < (unsigned)Lsub) ? x : -1e30f;
            acc[kt][i] = x; mx = fmaxf(mx, x);
        }
        __builtin_amdgcn_sched_barrier(0);
    }
    return mx;
}
__device__ __forceinline__ void attn_table(const Ctx& F, const Args& a) {
    LAS float* tab = (LAS float*)(F.lds + ATT_TAB);
    const float* rel_bias = a.in[3];
    __syncthreads();
    {
        constexpr int NE = 3 * NH * ATT_TABW, NK = (NE + NTHREADS - 1) / NTHREADS;
        int bi[NK]; float bv[NK];
#pragma unroll
        for (int k = 0; k < NK; ++k) {
            const int e = F.tid + k * NTHREADS, ec = e < NE ? e : 0;
            const int p = ec / (NH * ATT_TABW), h = (ec / ATT_TABW) % NH, dl = ec % ATT_TABW - 96;
            const bool ok = e < NE && dl >= -64 && dl <= 64;
            const int bk = (int)a.bkt[p][ok ? dl + 64 : 0];
            bi[k] = ok ? bk * NH + h : -1;
        }
#pragma unroll
        for (int k = 0; k < NK; ++k) bv[k] = rel_bias[bi[k] < 0 ? 0 : bi[k]];
#pragma unroll
        for (int k = 0; k < NK; ++k) { const int e = F.tid + k * NTHREADS; if (e < NE) tab[e] = bi[k] < 0 ? -1e30f : bv[k] * LOG2E; }
    }
    __syncthreads();
}
__device__ __forceinline__ void attn_phase(const Ctx& F, const Args& a, unsigned* qhead) {
    constexpr int NU = 3 * 1024;
    const bf16_t* Q = (const bf16_t*)(F.ws + WS_Q); const bf16_t* Kb = (const bf16_t*)(F.ws + WS_K); const bf16_t* Vb = (const bf16_t*)(F.ws + WS_V);
    unsigned char* OP = F.ws + WS_OP; float* LSE = (float*)(F.ws + WS_LSE); float* OSC = (float*)(F.ws + WS_OSC);
    LAS unsigned char* lds = F.lds;
    LAS float* tab = (LAS float*)(lds + ATT_TAB);
    const float* rel_bias = a.in[3];
    __syncthreads();
    const int lane = F.lane, w = F.wave, ql = lane & 31, hh = lane >> 5;
    const int tq = (lane & 15) >> 2, tp = lane & 3, tblk = (lane >> 4) & 1;
    volatile LAS unsigned* uq = (volatile LAS unsigned*)(lds + MISC_OFF) + 16;
    if (F.tid == 0) { const unsigned v0 = atomicAdd(qhead, 3u); uq[0] = v0; uq[1] = v0 + 2u; }
    __syncthreads();
    int ucur = (int)uq[0], unxt = ucur + 1;
    if (ucur >= NU) { __syncthreads(); return; }
    AttnUnit U = attn_decode(ucur);
    attn_stage_dma<false>(lds, Kb, U, F.tid, w);
    bf16x8 qf[4];
    { const size_t tq0 = (size_t)U.b * SEQ + ((size_t)(U.jblk + 32 * w + ql) << U.dsh) + U.r;
#pragma unroll
      for (int ks = 0; ks < 4; ++ks) qf[ks] = *(const bf16x8*)(Q + tq0 * AW + U.h * HD + 16 * ks + 8 * hh); }
    for (;;) {
        const bool has_next = unxt < NU;
        const AttnUnit N = attn_decode(has_next ? unxt : ucur);
        const int d = 1 << U.dsh;
        const int jq = U.jblk + 32 * w + ql;
        const size_t tokq = (size_t)U.b * SEQ + (size_t)jq * d + U.r;
        asm volatile("s_waitcnt vmcnt(0)" ::: "memory");
        __syncthreads();
        const int unn = (int)uq[1];
        unsigned grabbed = 0u; if (F.tid == 0) grabbed = atomicAdd(qhead, 1u);
        attn_stage_dma<true>(lds, Vb, U, F.tid, w);
        f32x16 acc[5];
#pragma unroll
        for (int kt = 0; kt < 5; ++kt) {
            const int rowk = 32 * w + 32 * kt + ql;
            bf16x8 kf[4];
#pragma unroll
            for (int ks = 0; ks < 4; ++ks) kf[ks] = *(const LAS bf16x8*)(lds + ATT_KT + rowk * 128 + (((2 * ks + hh) ^ ((rowk >> 1) & 7)) << 4));
#pragma unroll
            for (int i = 0; i < 16; ++i) acc[kt][i] = 0.f;
#pragma unroll
            for (int ks = 0; ks < 4; ++ks) acc[kt] = __builtin_amdgcn_mfma_f32_32x32x16_bf16(kf[ks], qf[ks], acc[kt], 0, 0, 0);
        }
        if (has_next) { const size_t tqn = (size_t)N.b * SEQ + ((size_t)(N.jblk + 32 * w + ql) << N.dsh) + N.r;
#pragma unroll
            for (int ks = 0; ks < 4; ++ks) qf[ks] = *(const bf16x8*)(Q + tqn * AW + N.h * HD + 16 * ks + 8 * hh); }
        const LAS float* tb = tab + (U.p * NH + U.h) * ATT_TABW + (32 - ql + 4 * hh);
        const int kp0 = U.jblk + 32 * w - 64 + 4 * hh;
        const bool edge = (U.jblk + 32 * w - 64 < 0) || (U.jblk + 32 * w + 96 > U.Lsub);
        float mx = edge ? attn_logits<true>(acc, tb, kp0, U.Lsub) : attn_logits<false>(acc, tb, kp0, U.Lsub);
        mx = fmaxf(mx, __shfl_xor(mx, 32));
        float sum = 0.f;
        bf16x8 pf[5][2];
#pragma unroll
        for (int kt = 0; kt < 5; ++kt) {
#pragma unroll
            for (int i = 0; i < 16; ++i) { const float e = __builtin_amdgcn_exp2f(acc[kt][i] - mx); acc[kt][i] = e; sum += e; }
#pragma unroll
            for (int s = 0; s < 2; ++s) {
                u32x4 wv; wv.x = pk2(acc[kt][8 * s + 0], acc[kt][8 * s + 1]); wv.y = pk2(acc[kt][8 * s + 2], acc[kt][8 * s + 3]);
                wv.z = pk2(acc[kt][8 * s + 4], acc[kt][8 * s + 5]); wv.w = pk2(acc[kt][8 * s + 6], acc[kt][8 * s + 7]);
                pf[kt][s] = __builtin_bit_cast(bf16x8, wv);
            }
        }
        sum += __shfl_xor(sum, 32);
        asm volatile("s_waitcnt vmcnt(0)" ::: "memory");
        __syncthreads();
        if (F.tid == 0) uq[1] = grabbed;
        if (has_next) attn_stage_dma<false>(lds, Kb, N, F.tid, w);
        f32x16 o[2];
#pragma unroll
        for (int dt = 0; dt < 2; ++dt)
#pragma unroll
            for (int i = 0; i < 16; ++i) o[dt][i] = 0.f;
        const int sw = (tq >> 1) & 1;
        const int vrow0 = 32 * w + 4 * hh + tq;
        const unsigned vb0 = ATT_VT + vrow0 * 128 + ((((0 ^ sw) << 2) + 2 * tblk + (tp >> 1)) << 4) + 8 * (tp & 1);
        const unsigned vb1 = ATT_VT + vrow0 * 128 + ((((1 ^ sw) << 2) + 2 * tblk + (tp >> 1)) << 4) + 8 * (tp & 1);
        {
            s16x4 tr[2][4];
#define ATT_TRLOAD(buf, st) do { const int _ro = (16 * (st)) * 128; \
                tr[buf][0] = __builtin_amdgcn_ds_read_tr16_b64_v4i16((LAS s16x4*)(lds + vb0 + _ro)); tr[buf][1] = __builtin_amdgcn_ds_read_tr16_b64_v4i16((LAS s16x4*)(lds + vb0 + _ro + 8 * 128)); \
                tr[buf][2] = __builtin_amdgcn_ds_read_tr16_b64_v4i16((LAS s16x4*)(lds + vb1 + _ro)); tr[buf][3] = __builtin_amdgcn_ds_read_tr16_b64_v4i16((LAS s16x4*)(lds + vb1 + _ro + 8 * 128)); } while (0)
            ATT_TRLOAD(0, 0);
#pragma unroll
            for (int st = 0; st < 10; ++st) {
                if (st + 1 < 10) ATT_TRLOAD((st + 1) & 1, st + 1);
                const s16x4 l0 = tr[st & 1][0], h0 = tr[st & 1][1], l1 = tr[st & 1][2], h1 = tr[st & 1][3];
                const bf16x8 a0 = (bf16x8){l0[0], l0[1], l0[2], l0[3], h0[0], h0[1], h0[2], h0[3]};
                const bf16x8 a1 = (bf16x8){l1[0], l1[1], l1[2], l1[3], h1[0], h1[1], h1[2], h1[3]};
                o[0] = __builtin_amdgcn_mfma_f32_32x32x16_bf16(a0, pf[st >> 1][st & 1], o[0], 0, 0, 0);
                o[1] = __builtin_amdgcn_mfma_f32_32x32x16_bf16(a1, pf[st >> 1][st & 1], o[1], 0, 0, 0);
            }
#undef ATT_TRLOAD
        }
        const float inv = 1.f / sum;
        float am = 0.f;
#pragma unroll
        for (int dt = 0; dt < 2; ++dt)
#pragma unroll
            for (int i = 0; i < 16; ++i) am = fmaxf(am, fabsf(o[dt][i]));
        { const unsigned a_ = __builtin_bit_cast(unsigned, am); const auto r_ = __builtin_amdgcn_permlane32_swap(a_, a_, false, false); const unsigned r0 = r_[0], r1 = r_[1];
          am = fmaxf(__builtin_bit_cast(float, r0), __builtin_bit_cast(float, r1)); }
        const float qs = am > 0.f ? 127.f / am : 0.f;
        {
            LAS unsigned char* ost = lds + ATT_OST + w * (32 * ATT_OROW);
#pragma unroll
            for (int dt = 0; dt < 2; ++dt)
#pragma unroll
                for (int rq = 0; rq < 4; ++rq)
                    *(LAS unsigned*)(ost + ql * ATT_OROW + 32 * dt + 8 * rq + 4 * hh) = pk4_i8(o[dt][4 * rq + 0] * qs, o[dt][4 * rq + 1] * qs, o[dt][4 * rq + 2] * qs, o[dt][4 * rq + 3] * qs) ^ 0x80808080u;
            asm volatile("s_waitcnt lgkmcnt(0)" ::: "memory");
            const int orq = lane >> 2, oc = lane & 3;
#pragma unroll
            for (int rr = 0; rr < 2; ++rr) {
                const int row = 16 * rr + orq;
                const u32x4 v = *(const LAS u32x4*)(ost + row * ATT_OROW + 16 * oc);
                const size_t tokr = (size_t)U.b * SEQ + (size_t)(U.jblk + 32 * w + row) * d + U.r;
                *(u32x4*)(OP + ((size_t)U.p * TOK + tokr) * AW + U.h * HD + 16 * oc) = v;
            }
        }
        if (hh == 0) { LSE[((size_t)U.p * TOK + tokq) * NH + U.h] = (mx + __builtin_amdgcn_logf(sum)) * LN2; OSC[((size_t)U.p * TOK + tokq) * NH + U.h] = am * inv * (1.f / 127.f); }
        if (!has_next) break;
        U = N; ucur = unxt; unxt = unn;
    }
    __syncthreads();
}

__device__ __forceinline__ void carry_unit(const Ctx& F, const Args& a, int l, int g, int pml) {
    const float* E = (const float*)(F.ws + WS_E); bf16_t* UX = (bf16_t*)(F.ws + WS_UX);
    const f32x2* LAML = (const f32x2*)(F.ws + WS_LAML);
    if (F.tid < 256) {
        const int p = F.tid & 63, dir = (F.tid >> 6) & 1, b = 2 * pml + (F.tid >> 7);
        const f32x2 lm = LAML[((l * 2 + dir) * SG + g) * SP + p];
        float sr = 0.f, si = 0.f;
        const size_t rbase = (size_t)g * ROWS_G + (size_t)b * NCHUNK;
        for (int cb = 0; cb < NCHUNK; cb += 32) {
            float er[32], ei[32];
#pragma unroll
            for (int j = 0; j < 32; ++j) { const int c = dir ? NCHUNK - 1 - (cb + j) : cb + j; const float* ep = E + (rbase + c) * N1 + dir * 128 + p; er[j] = ep[0]; ei[j] = ep[64]; }
#pragma unroll
            for (int j = 0; j < 32; ++j) {
                const int c = dir ? NCHUNK - 1 - (cb + j) : cb + j;
                bf16_t* up = UX + (rbase + c) * K2 + K1 + dir * 128 + p;
                up[0] = (bf16_t)f2bf(sr); up[64] = (bf16_t)f2bf(si);
                const float nr = er[j] + lm.x * sr - lm.y * si, ni = ei[j] + lm.x * si + lm.y * sr;
                sr = nr; si = ni;
            }
        }
    }
}

__device__ __forceinline__ void mixprep_phase(const Ctx& F, const Args& a, int l) {
    const unsigned char* OP = F.ws + WS_OP; const float* LSE = (const float*)(F.ws + WS_LSE); const float* OSC = (const float*)(F.ws + WS_OSC); const bf16_t* SS = (const bf16_t*)(F.ws + WS_SSM);
    unsigned char* H = F.ws + WS_H; float* HS = (float*)(F.ws + WS_HSC);
    const float* ga = a.in[4] + l * AW; const float* gs = a.in[5] + l * SW;
    const int lane = F.lane, hd = lane >> 3;
    constexpr int NT = 4;
    const f32x4 g0 = *(const f32x4*)(ga + lane * 8), g1 = *(const f32x4*)(ga + lane * 8 + 4), h0 = *(const f32x4*)(gs + lane * 8), h1 = *(const f32x4*)(gs + lane * 8 + 4);
    for (int tb = (F.bid * NWAVES + F.wave) * NT; tb < TOK; tb += F.G * NWAVES * NT) {
        u32x2 o[NT][3]; float ls[NT][3], oq[NT][3]; u32x4 sv[NT];
#pragma unroll
        for (int r = 0; r < NT; ++r) {
            const int t = tb + r;
#pragma unroll
            for (int p = 0; p < 3; ++p) { o[r][p] = *(const u32x2*)(OP + ((size_t)p * TOK + t) * AW + lane * 8); ls[r][p] = LSE[((size_t)p * TOK + t) * NH + hd]; oq[r][p] = OSC[((size_t)p * TOK + t) * NH + hd]; }
            sv[r] = *(const u32x4*)(SS + (size_t)t * SW + lane * 8);
        }
#pragma unroll
        for (int r = 0; r < NT; ++r) {
            const int t = tb + r;
            const float mx = fmaxf(ls[r][0], fmaxf(ls[r][1], ls[r][2]));
            float w0 = __expf(ls[r][0] - mx), w1 = __expf(ls[r][1] - mx), w2 = __expf(ls[r][2] - mx);
            const float wi = 1.f / (w0 + w1 + w2); w0 *= wi * oq[r][0]; w1 *= wi * oq[r][1]; w2 *= wi * oq[r][2];
            const float woff = -128.f * (w0 + w1 + w2);
            float av[8], sq = 0.f;
#pragma unroll
            for (int k = 0; k < 8; ++k) {
                const unsigned b0 = (o[r][0][k >> 2] >> (8 * (k & 3))) & 255u, b1 = (o[r][1][k >> 2] >> (8 * (k & 3))) & 255u, b2 = (o[r][2][k >> 2] >> (8 * (k & 3))) & 255u;
                av[k] = (w0 * (float)b0 + w1 * (float)b1) + (w2 * (float)b2 + woff);
                sq += av[k] * av[k];
            }
            float sv8[8], sq2 = 0.f;
#pragma unroll
            for (int j = 0; j < 4; ++j) { sv8[2 * j] = bflo(sv[r][j]); sv8[2 * j + 1] = bfhi(sv[r][j]); sq2 += sv8[2 * j] * sv8[2 * j] + sv8[2 * j + 1] * sv8[2 * j + 1]; }
            const float ia = rsqrtf(wave_sum(sq) * (1.f / AW) + EPS), is = rsqrtf(wave_sum(sq2) * (1.f / SW) + EPS);
            float qmx = 0.f;
#pragma unroll
            for (int j = 0; j < 4; ++j) { av[j] *= ia * g0[j]; av[4 + j] *= ia * g1[j]; sv8[j] *= is * h0[j]; sv8[4 + j] *= is * h1[j]; }
#pragma unroll
            for (int j = 0; j < 8; ++j) qmx = fmaxf(qmx, fmaxf(fabsf(av[j]), fabsf(sv8[j])));
            qmx = wave_max(qmx);
            const float sc = qmx > 0.f ? qmx * (1.f / 127.f) : 1.f, qs = 1.f / sc;
            u32x2 wa; wa.x = pk4_i8(av[0] * qs, av[1] * qs, av[2] * qs, av[3] * qs); wa.y = pk4_i8(av[4] * qs, av[5] * qs, av[6] * qs, av[7] * qs);
            u32x2 wb; wb.x = pk4_i8(sv8[0] * qs, sv8[1] * qs, sv8[2] * qs, sv8[3] * qs); wb.y = pk4_i8(sv8[4] * qs, sv8[5] * qs, sv8[6] * qs, sv8[7] * qs);
            *(u32x2*)(H + (size_t)t * DM + lane * 8) = wa;
            *(u32x2*)(H + (size_t)t * DM + AW + lane * 8) = wb;
            if (lane == 0) HS[t] = sc;
        }
    }
}

__device__ __forceinline__ unsigned ord_f(float f) { const int u = __builtin_bit_cast(int, f); return (unsigned)u ^ ((unsigned)(u >> 31) | 0x80000000u); }
__device__ __forceinline__ float unord_f(unsigned k) { return __builtin_bit_cast(float, (k & 0x80000000u) ? (k ^ 0x80000000u) : ~k); }
#define CE_D(x, y) { const unsigned _a = (x), _b = (y); (x) = _a > _b ? _a : _b; (y) = _a > _b ? _b : _a; }
#define CE_A(x, y) { const unsigned _a = (x), _b = (y); (x) = _a > _b ? _b : _a; (y) = _a > _b ? _a : _b; }
template <int B0> __device__ __forceinline__ void sort16_desc(unsigned (&v)[64]) {
    CE_D(v[B0 + 0], v[B0 + 13]); CE_D(v[B0 + 1], v[B0 + 12]); CE_D(v[B0 + 2], v[B0 + 15]); CE_D(v[B0 + 3], v[B0 + 14]); CE_D(v[B0 + 4], v[B0 + 8]); CE_D(v[B0 + 5], v[B0 + 6]); CE_D(v[B0 + 7], v[B0 + 11]); CE_D(v[B0 + 9], v[B0 + 10]);
    CE_D(v[B0 + 0], v[B0 + 5]); CE_D(v[B0 + 1], v[B0 + 7]); CE_D(v[B0 + 2], v[B0 + 9]); CE_D(v[B0 + 3], v[B0 + 4]); CE_D(v[B0 + 6], v[B0 + 13]); CE_D(v[B0 + 8], v[B0 + 14]); CE_D(v[B0 + 10], v[B0 + 15]); CE_D(v[B0 + 11], v[B0 + 12]);
    CE_D(v[B0 + 0], v[B0 + 1]); CE_D(v[B0 + 2], v[B0 + 3]); CE_D(v[B0 + 4], v[B0 + 5]); CE_D(v[B0 + 6], v[B0 + 8]); CE_D(v[B0 + 7], v[B0 + 9]); CE_D(v[B0 + 10], v[B0 + 11]); CE_D(v[B0 + 12], v[B0 + 13]); CE_D(v[B0 + 14], v[B0 + 15]);
    CE_D(v[B0 + 0], v[B0 + 2]); CE_D(v[B0 + 1], v[B0 + 3]); CE_D(v[B0 + 4], v[B0 + 10]); CE_D(v[B0 + 5], v[B0 + 11]); CE_D(v[B0 + 6], v[B0 + 7]); CE_D(v[B0 + 8], v[B0 + 9]); CE_D(v[B0 + 12], v[B0 + 14]); CE_D(v[B0 + 13], v[B0 + 15]);
    CE_D(v[B0 + 1], v[B0 + 2]); CE_D(v[B0 + 3], v[B0 + 12]); CE_D(v[B0 + 4], v[B0 + 6]); CE_D(v[B0 + 5], v[B0 + 7]); CE_D(v[B0 + 8], v[B0 + 10]); CE_D(v[B0 + 9], v[B0 + 11]); CE_D(v[B0 + 13], v[B0 + 14]);
    CE_D(v[B0 + 1], v[B0 + 4]); CE_D(v[B0 + 2], v[B0 + 6]); CE_D(v[B0 + 5], v[B0 + 8]); CE_D(v[B0 + 7], v[B0 + 10]); CE_D(v[B0 + 9], v[B0 + 13]); CE_D(v[B0 + 11], v[B0 + 14]);
    CE_D(v[B0 + 2], v[B0 + 4]); CE_D(v[B0 + 3], v[B0 + 6]); CE_D(v[B0 + 9], v[B0 + 12]); CE_D(v[B0 + 11], v[B0 + 13]);
    CE_D(v[B0 + 3], v[B0 + 5]); CE_D(v[B0 + 6], v[B0 + 8]); CE_D(v[B0 + 7], v[B0 + 9]); CE_D(v[B0 + 10], v[B0 + 12]);
    CE_D(v[B0 + 3], v[B0 + 4]); CE_D(v[B0 + 5], v[B0 + 6]); CE_D(v[B0 + 7], v[B0 + 8]); CE_D(v[B0 + 9], v[B0 + 10]); CE_D(v[B0 + 11], v[B0 + 12]);
    CE_D(v[B0 + 6], v[B0 + 7]); CE_D(v[B0 + 8], v[B0 + 9]);
}
template <int A0> __device__ __forceinline__ void bmerge16_desc(unsigned (&v)[64]) {
#pragma unroll
    for (int j = 8; j > 0; j >>= 1)
#pragma unroll
        for (int i = 0; i < 16; ++i) { const int l = i ^ j; if (l > i) { CE_D(v[A0 + i], v[A0 + l]); } }
}
template <int A0, int B0> __device__ __forceinline__ void merge_top16(unsigned (&v)[64]) {
#pragma unroll
    for (int i = 0; i < 16; ++i) { const unsigned x = v[A0 + i], y = v[B0 + 15 - i]; v[A0 + i] = x > y ? x : y; }
    bmerge16_desc<A0>(v);
}
__device__ __forceinline__ void top16_of_64(unsigned (&v)[64]) {
    sort16_desc<0>(v); sort16_desc<16>(v); sort16_desc<32>(v); sort16_desc<48>(v);
    merge_top16<0, 16>(v); merge_top16<32, 48>(v); merge_top16<0, 32>(v);
}
__device__ __forceinline__ void cross_half_top16(unsigned (&v)[64]) {
#pragma unroll
    for (int i = 0; i < 16; ++i) v[16 + i] = (unsigned)__shfl_xor((int)v[i], 32);
    merge_top16<0, 16>(v);
}

__device__ __forceinline__ void topk_block(const Ctx& F, const Args& a, int l, int tb) {
    const bf16_t* QB = (const bf16_t*)(F.ws + WS_QB); const bf16_t* SK = (const bf16_t*)(F.ws + WS_SK);
    unsigned short* EID = (unsigned short*)(F.ws + WS_EID); bf16_t* GATE = (bf16_t*)(F.ws + WS_GATE);
    const int lane = F.lane, tl = lane & 31, hh = lane >> 5;
    for (int r4 = 0; r4 < 4; ++r4) {
        const int tg = 4 * tb + r4, h = F.wave;
        const size_t tok = (size_t)tg * 32 + tl;
        unsigned t12[2][16];
#pragma unroll
        for (int part = 0; part < 2; ++part) {
            bf16x8 qf[4];
#pragma unroll
            for (int ks = 0; ks < 4; ++ks) qf[ks] = *(const bf16x8*)(QB + tok * DM + h * PQD + part * 64 + 16 * ks + 8 * hh);
            const bf16_t* skb = SK + (size_t)(((l * 2 + part) * PH + h) * PKEYS) * 64;
            unsigned v[64];
            bf16x8 kfr[4][4];
#pragma unroll
            for (int kt = 0; kt < 4; ++kt)
#pragma unroll
                for (int ks = 0; ks < 4; ++ks) kfr[kt][ks] = *(const bf16x8*)(skb + (size_t)(32 * kt + tl) * 64 + 16 * ks + 8 * hh);
#pragma unroll
            for (int kt = 0; kt < 4; ++kt)
#pragma unroll
                for (int ks = 0; ks < 4; ++ks) asm volatile("" : "+v"(kfr[kt][ks]));
#pragma unroll
            for (int kt = 0; kt < 4; ++kt) {
                f32x16 acc;
#pragma unroll
                for (int i = 0; i < 16; ++i) acc[i] = 0.f;
#pragma unroll
                for (int ks = 0; ks < 4; ++ks) acc = __builtin_amdgcn_mfma_f32_32x32x16_bf16(kfr[kt][ks], qf[ks], acc, 0, 0, 0);
#pragma unroll
                for (int i = 0; i < 16; ++i) { const int key = 32 * kt + (i & 3) + 8 * (i >> 2) + 4 * hh; v[16 * kt + i] = (ord_f(acc[i]) & ~127u) | (unsigned)(127 - key); }
            }
            top16_of_64(v);
            cross_half_top16(v);
#pragma unroll
            for (int i = 0; i < 16; ++i) t12[part][i] = v[i];
        }
        float f1[16], f2[16];
#pragma unroll
        for (int i = 0; i < 16; ++i) { f1[i] = unord_f(t12[0][i] & ~127u); f2[i] = unord_f(t12[1][i] & ~127u); }
        unsigned v[64];
        {
            int n = 0, pa = 0, pb = 0;
#pragma unroll
            for (int aa = 0; aa < 16; ++aa)
#pragma unroll
                for (int bb = 0; bb < 16; ++bb)
                    if ((aa + 1) * (bb + 1) <= 16) {
                        if ((n & 1) == 0) { pa = aa; pb = bb; }
                        else { const float sm = (hh ? f1[aa] : f1[pa]) + (hh ? f2[bb] : f2[pb]); const unsigned tag = hh ? (unsigned)(255 - (16 * aa + bb)) : (unsigned)(255 - (16 * pa + pb));
                               v[n >> 1] = (ord_f(sm) & ~255u) | tag; }
                        ++n;
                    }
#pragma unroll
            for (int i = 25; i < 32; ++i) v[i] = 0u;
        }
        sort16_desc<0>(v); sort16_desc<16>(v); merge_top16<0, 16>(v);
        cross_half_top16(v);
        unsigned i1p[4], i2p[4];
#pragma unroll
        for (int w4 = 0; w4 < 4; ++w4) {
            i1p[w4] = (127u - (t12[0][4 * w4] & 127u)) | ((127u - (t12[0][4 * w4 + 1] & 127u)) << 8) | ((127u - (t12[0][4 * w4 + 2] & 127u)) << 16) | ((127u - (t12[0][4 * w4 + 3] & 127u)) << 24);
            i2p[w4] = (127u - (t12[1][4 * w4] & 127u)) | ((127u - (t12[1][4 * w4 + 1] & 127u)) << 8) | ((127u - (t12[1][4 * w4 + 2] & 127u)) << 16) | ((127u - (t12[1][4 * w4 + 3] & 127u)) << 24);
        }
        float sc[8]; int ex[8];
        float den = 0.f; const float s0 = unord_f(v[0] & ~255u);
#pragma unroll
        for (int i = 0; i < 8; ++i) {
            const unsigned vi = hh ? v[8 + i] : v[i];
            const unsigned cell = 255u - (vi & 255u), ca = cell >> 4, cb = cell & 15u;
            const unsigned wa = (ca >> 2) == 0 ? i1p[0] : (ca >> 2) == 1 ? i1p[1] : (ca >> 2) == 2 ? i1p[2] : i1p[3];
            const unsigned wb = (cb >> 2) == 0 ? i2p[0] : (cb >> 2) == 1 ? i2p[1] : (cb >> 2) == 2 ? i2p[2] : i2p[3];
            const unsigned e1 = (wa >> (8 * (ca & 3u))) & 255u, e2 = (wb >> (8 * (cb & 3u))) & 255u;
            ex[i] = (int)(e1 * PKEYS + e2);
            sc[i] = __expf(unord_f(vi & ~255u) - s0); den += sc[i];
        }
        { const unsigned da = __builtin_bit_cast(unsigned, den); const auto r = __builtin_amdgcn_permlane32_swap(da, da, false, false); const unsigned r0 = r[0], r1 = r[1]; den = __builtin_bit_cast(float, r0) + __builtin_bit_cast(float, r1); }
        const float iden = 1.f / den;
        u32x4 e0, g0;
        e0.x = (unsigned)ex[0] | ((unsigned)ex[1] << 16); e0.y = (unsigned)ex[2] | ((unsigned)ex[3] << 16); e0.z = (unsigned)ex[4] | ((unsigned)ex[5] << 16); e0.w = (unsigned)ex[6] | ((unsigned)ex[7] << 16);
        g0.x = pk2(sc[0] * iden, sc[1] * iden); g0.y = pk2(sc[2] * iden, sc[3] * iden); g0.z = pk2(sc[4] * iden, sc[5] * iden); g0.w = pk2(sc[6] * iden, sc[7] * iden);
        const size_t ob = tok * PSEL + h * PTOP + 8 * hh;
        *(u32x4*)(EID + ob) = e0;
        *(u32x4*)(GATE + ob) = g0;
    }
}

constexpr int G_LPP = GCH / 16;
constexpr int G_EPL = 64 / G_LPP;
constexpr int G_NLD = PSEL / G_EPL;
constexpr int G_LOGL = 3;
static_assert(G_LPP == 8 && G_EPL == 8 && G_NLD == 16, "gather geometry");
constexpr int G_TPW = 16;
struct GTask { u32x4 ld[G_NLD]; u32x4 hp; unsigned xo; };
#ifndef PROBE_GMODE
#define PROBE_GMODE 1
#endif
template <bool PB, int MODE>
__device__ __forceinline__ void g_issue(GTask& T, const unsigned char* tab, const unsigned char* HQ, const bf16_t* X, const LAS unsigned short* wids, int c, int m, size_t t0, int g, int i) {
#ifndef PROBE_DUP
#define PROBE_DUP 0
#endif
    const int gdup = (MODE != 0 && PROBE_DUP == 1) ? (g & ~1) : (MODE != 0 && PROBE_DUP == 3) ? (g & ~3) : g;
    const LAS unsigned short* ep = wids + (m * G_EPL + gdup) * G_NLD;
    unsigned ids[G_NLD];
#pragma unroll
    for (int k8 = 0; k8 < G_NLD / 8; ++k8) { const u32x4 p = *(const LAS u32x4*)(ep + 8 * k8);
#pragma unroll
        for (int k = 0; k < 4; ++k) { ids[8 * k8 + 2 * k] = p[k] & 0xffffu; ids[8 * k8 + 2 * k + 1] = p[k] >> 16; } }
    if (MODE != 0 && PROBE_DUP == 2) {
#pragma unroll
        for (int k = 0; k < G_NLD; ++k) ids[k] = ids[k & ~1];
    }
    const unsigned char* base = tab + (size_t)c * NEXP * GCH + 16 * i;
    if (MODE >= 3) {
#pragma unroll
        for (int k = 0; k < G_NLD; ++k) T.ld[k] = (u32x4){ids[k], ids[k] * 3u, ids[k] + 77u, ids[k] ^ 0x55u};
    } else {
#pragma unroll
        for (int k = 0; k < G_NLD; ++k) T.ld[k] = *(const u32x4*)(base + (size_t)ids[k] * GCH);
    }
    const size_t t = t0 + m;
    if (!PB) T.hp = *(const u32x4*)(HQ + t * DM + c * GCH + 16 * i);
    else T.xo = *(const unsigned*)(X + t * DM + c * GCH + 16 * i + 2 * (g & 7));
}
template <int MODE>
__device__ __forceinline__ void g_compute_a(const GTask& T, LAS int* wact, int m, int g, int i, int lane) {
    if (MODE == 2) {
#pragma unroll
        for (int k = 0; k < G_NLD; ++k) asm volatile("" :: "v"(T.ld[k]));
        asm volatile("" :: "v"(T.hp));
        return;
    }
    int s[G_NLD];
#pragma unroll
    for (int k = 0; k < G_NLD; ++k) { int v = 0;
#pragma unroll
        for (int q = 0; q < 4; ++q) v = __builtin_amdgcn_sdot4((int)T.ld[k][q], (int)T.hp[q], v, false);
        s[k] = v; }
#pragma unroll
    for (int st = 0; st < G_LOGL; ++st) {
        const bool bit = (lane >> st) & 1;
#pragma unroll
        for (int mm = 0; mm < (G_NLD >> (st + 1)); ++mm) {
            const int x = bit ? s[2 * mm + 1] : s[2 * mm], y = bit ? s[2 * mm] : s[2 * mm + 1];
            s[mm] = x + __shfl_xor(y, 1 << st);
        }
    }
    LAS int* ap = wact + (m * G_EPL + g) * G_NLD + i;
    __hip_atomic_fetch_add(ap, s[0], __ATOMIC_RELAXED, __HIP_MEMORY_SCOPE_WORKGROUP);
    __hip_atomic_fetch_add(ap + G_LPP, s[1], __ATOMIC_RELAXED, __HIP_MEMORY_SCOPE_WORKGROUP);
}
template <int MODE>
__device__ __forceinline__ void g_compute_b(const GTask& T, const LAS unsigned char* wq, const LAS float* wsc, bf16_t* X, int c, int m, size_t t0, int g, int i, int lane) {
    if (MODE == 2) {
#pragma unroll
        for (int k = 0; k < G_NLD; ++k) asm volatile("" :: "v"(T.ld[k]));
        asm volatile("" :: "v"(T.xo));
        return;
    }
    const u32x4 w4 = *(const LAS u32x4*)(wq + (m * G_EPL + g) * G_NLD);
    int acc[16];
#pragma unroll
    for (int j = 0; j < 16; ++j) acc[j] = 0;
#pragma unroll
    for (int kq = 0; kq < G_NLD / 4; ++kq)
#pragma unroll
        for (int q = 0; q < 4; ++q) {
            const unsigned d0 = T.ld[4 * kq][q], d1 = T.ld[4 * kq + 1][q], d2 = T.ld[4 * kq + 2][q], d3 = T.ld[4 * kq + 3][q];
            const unsigned p0 = __builtin_amdgcn_perm(d1, d0, 0x05010400u), p1 = __builtin_amdgcn_perm(d1, d0, 0x07030602u);
            const unsigned q0 = __builtin_amdgcn_perm(d3, d2, 0x05010400u), q1 = __builtin_amdgcn_perm(d3, d2, 0x07030602u);
            const unsigned t0_ = __builtin_amdgcn_perm(q0, p0, 0x05040100u), t1_ = __builtin_amdgcn_perm(q0, p0, 0x07060302u);
            const unsigned t2_ = __builtin_amdgcn_perm(q1, p1, 0x05040100u), t3_ = __builtin_amdgcn_perm(q1, p1, 0x07060302u);
            acc[4 * q] = __builtin_amdgcn_sdot4((int)t0_, (int)w4[kq], acc[4 * q], false);
            acc[4 * q + 1] = __builtin_amdgcn_sdot4((int)t1_, (int)w4[kq], acc[4 * q + 1], false);
            acc[4 * q + 2] = __builtin_amdgcn_sdot4((int)t2_, (int)w4[kq], acc[4 * q + 2], false);
            acc[4 * q + 3] = __builtin_amdgcn_sdot4((int)t3_, (int)w4[kq], acc[4 * q + 3], false);
        }
#pragma unroll
    for (int mm = 0; mm < 8; ++mm) { const auto r_ = __builtin_amdgcn_permlane32_swap((unsigned)acc[mm], (unsigned)acc[mm + 8], false, false); acc[mm] = (int)(r_[0] + r_[1]); }
#pragma unroll
    for (int mm = 0; mm < 4; ++mm) { const auto r_ = __builtin_amdgcn_permlane16_swap((unsigned)acc[mm], (unsigned)acc[mm + 4], false, false); acc[mm] = (int)(r_[0] + r_[1]); }
    { const bool b3 = lane & 8;
#pragma unroll
      for (int mm = 0; mm < 2; ++mm) { const int t_ = acc[mm] + __builtin_amdgcn_update_dpp(0, acc[mm], 0x128, 0xf, 0xf, false), u_ = acc[mm + 2] + __builtin_amdgcn_update_dpp(0, acc[mm + 2], 0x128, 0xf, 0xf, false);
          acc[mm] = b3 ? u_ : t_; } }
    const float sc = wsc[m];
    if (MODE == 0) {
        const float x0 = bflo(T.xo) + sc * (float)acc[0], x1 = bfhi(T.xo) + sc * (float)acc[1];
        *(unsigned*)(X + (t0 + m) * DM + c * GCH + 16 * i + 2 * (g & 7)) = pk2(x0, x1);
    } else asm volatile("" :: "v"(acc[0]), "v"(acc[1]), "v"(sc));
}

constexpr int GS_LIST = 0, GS_CNT = 65536, GS_ACT = 65536, GS_HN = 131072, GS_WT = 131072, GS_SEG = 256;
struct GTaskA { u32x4 ld[G_NLD]; unsigned ent[G_NLD]; };
template <int PM>
__device__ __forceinline__ void gsort_block(const Ctx& F, const unsigned short* EIDb  ) {
    LAS unsigned* cnt = (LAS unsigned*)(F.lds + GS_CNT);
    LAS unsigned* list = (LAS unsigned*)(F.lds + GS_LIST);
    LAS unsigned* wt = (LAS unsigned*)(F.lds + GS_WT);
    const int tid = F.tid, lane = F.lane;
    unsigned er[32];
#pragma unroll
    for (int j = 0; j < 32; ++j) er[j] = (unsigned)EIDb[j * NTHREADS + tid];
#pragma unroll
    for (int j = 0; j < 8; ++j) *(LAS u32x4*)(cnt + (j * NTHREADS + tid) * 4) = (u32x4){0u, 0u, 0u, 0u};
    asm volatile("s_waitcnt lgkmcnt(0)" ::: "memory"); __builtin_amdgcn_s_barrier(); asm volatile("" ::: "memory");
#pragma unroll
    for (int j = 0; j < 32; ++j) { const unsigned r = __hip_atomic_fetch_add(cnt + er[j], 1u, __ATOMIC_RELAXED, __HIP_MEMORY_SCOPE_WORKGROUP); er[j] |= r << 14; }
    asm volatile("s_waitcnt lgkmcnt(0)" ::: "memory"); __builtin_amdgcn_s_barrier(); asm volatile("" ::: "memory");
    u32x4 v[8]; unsigned sum = 0;
#pragma unroll
    for (int j = 0; j < 8; ++j) { v[j] = *(const LAS u32x4*)(cnt + (tid * 8 + j) * 4); sum += (v[j].x + v[j].y) + (v[j].z + v[j].w); }
    unsigned incl = sum;
#pragma unroll
    for (int d = 1; d < 64; d <<= 1) { const unsigned t = __shfl_up(incl, d); if (lane >= d) incl += t; }
    if (lane == 63) wt[F.wave] = incl;
    asm volatile("s_waitcnt lgkmcnt(0)" ::: "memory"); __builtin_amdgcn_s_barrier(); asm volatile("" ::: "memory");
    unsigned run = incl - sum;
#pragma unroll
    for (int w = 0; w < NWAVES - 1; ++w) run += (w < F.wave) ? wt[w] : 0u;
#pragma unroll
    for (int j = 0; j < 8; ++j) { u32x4 o; o.x = run; run += v[j].x; o.y = run; run += v[j].y; o.z = run; run += v[j].z; o.w = run; run += v[j].w; *(LAS u32x4*)(cnt + (tid * 8 + j) * 4) = o; }
    asm volatile("s_waitcnt lgkmcnt(0)" ::: "memory"); __builtin_amdgcn_s_barrier(); asm volatile("" ::: "memory");
#pragma unroll
    for (int j = 0; j < 32; ++j) { const unsigned e = er[j] & 0x3fffu, pos = (PM & 1) ? (unsigned)(j * NTHREADS + tid) : cnt[e] + (er[j] >> 14); list[pos] = (e << 14) | (unsigned)(j * NTHREADS + tid); }
    asm volatile("s_waitcnt lgkmcnt(0)" ::: "memory"); __builtin_amdgcn_s_barrier(); asm volatile("" ::: "memory");
}
template <int PM>
__device__ __forceinline__ void ga_issue(GTaskA& T, const unsigned char* tabc  , const LAS unsigned* lp  , unsigned i16) {
#pragma unroll
    for (int k4 = 0; k4 < G_NLD / 4; ++k4) { const u32x4 p = *(const LAS u32x4*)(lp + 4 * k4); T.ent[4 * k4] = p.x; T.ent[4 * k4 + 1] = p.y; T.ent[4 * k4 + 2] = p.z; T.ent[4 * k4 + 3] = p.w; }
#pragma unroll
    for (int k = 0; k < G_NLD; ++k) { if (PM & 4) T.ld[k] = (u32x4){T.ent[k], T.ent[k] * 3u, T.ent[k] + 77u, T.ent[k] ^ 0x55u}; else T.ld[k] = *(const u32x4*)(tabc + (((T.ent[k] >> 7) & ~127u) + i16)); }
}
template <int PM>
__device__ __forceinline__ void ga_compute(const GTaskA& T, unsigned hbv, const LAS unsigned* lp, LAS int* act, int i, int lane) {
    const unsigned e0 = lp[i], e1 = lp[8 + i];
    int zero = 0; asm volatile("" : "+v"(zero));
    int s[G_NLD];
#pragma unroll
    for (int kb = 0; kb < G_NLD; kb += 8) {
        u32x4 hp[8];
#pragma unroll
        for (int k = 0; k < 8; ++k) hp[k] = (PM & 2) ? (u32x4){T.ent[kb + k], T.ent[kb + k] >> 3, T.ent[kb + k] * 5u, T.ent[kb + k] + 1u} : *(const LAS u32x4*)(size_t)((T.ent[kb + k] & 0x3f80u) | hbv);
        asm volatile("" : "+v"(hp[0]), "+v"(hp[1]), "+v"(hp[2]), "+v"(hp[3]), "+v"(hp[4]), "+v"(hp[5]), "+v"(hp[6]), "+v"(hp[7]));
#pragma unroll
        for (int k = 0; k < 8; ++k) { int v = zero;
#pragma unroll
            for (int q = 0; q < 4; ++q) v = __builtin_amdgcn_sdot4((int)T.ld[kb + k][q], (int)hp[k][q], v, false);
            s[kb + k] = v; }
    }
    { const bool b0 = lane & 1, b1 = lane & 2, b2 = lane & 4;
#pragma unroll
      for (int mm = 0; mm < 8; ++mm) { const int t = s[2 * mm] + __builtin_amdgcn_update_dpp(0, s[2 * mm], 0xB1, 0xf, 0xf, false), u = s[2 * mm + 1] + __builtin_amdgcn_update_dpp(0, s[2 * mm + 1], 0xB1, 0xf, 0xf, false);
          s[mm] = b0 ? u : t; }
#pragma unroll
      for (int mm = 0; mm < 4; ++mm) { const int t = s[2 * mm] + __builtin_amdgcn_update_dpp(0, s[2 * mm], 0x4E, 0xf, 0xf, false), u = s[2 * mm + 1] + __builtin_amdgcn_update_dpp(0, s[2 * mm + 1], 0x4E, 0xf, 0xf, false);
          s[mm] = b1 ? u : t; }
#pragma unroll
      for (int mm = 0; mm < 2; ++mm) { const int x = b2 ? s[2 * mm + 1] : s[2 * mm], y = b2 ? s[2 * mm] : s[2 * mm + 1];
          int pr = __builtin_amdgcn_update_dpp(0, y, 0x104, 0xf, 0x5, false);
          pr = __builtin_amdgcn_update_dpp(pr, y, 0x114, 0xf, 0xa, false);
          s[mm] = x + pr; }
    }
    __hip_atomic_fetch_add(act + (e0 & 0x3fffu), s[0], __ATOMIC_RELAXED, __HIP_MEMORY_SCOPE_WORKGROUP);
    __hip_atomic_fetch_add(act + (e1 & 0x3fffu), s[1], __ATOMIC_RELAXED, __HIP_MEMORY_SCOPE_WORKGROUP);
}

constexpr int G_WAVE_LDS = 4096 + 2048 + 64;
static_assert(NWAVES * G_WAVE_LDS <= GS_CNT && GS_ACT + NWAVES * 8192 <= GS_HN && GS_HN + 2 * 16384 <= LDS_BYTES && GCH == 128 && PSEL == 128 && NTHREADS == 512, "gather LDS map");
template <int PM, int STAGE>
__device__ __forceinline__ void gather_a(const Ctx& F, const Args& a, int tb) {
    const unsigned char* EU = F.ws + WS_EU;
    const unsigned short* EID = (const unsigned short*)(F.ws + WS_EID);
    const unsigned char* HQ = F.ws + WS_H;
    const int lane = F.lane, g = lane / G_LPP, i = lane % G_LPP;
    {
            const size_t tb0 = (size_t)tb * 128;
            if (STAGE == 1) { gsort_block<PM>(F, EID + tb0 * PSEL); if (PM & 8) gsort_block<PM>(F, EID + tb0 * PSEL); return; }
            LAS unsigned char* hnb = F.lds + GS_HN;
            const LAS unsigned* lq = (const LAS unsigned*)(F.lds + GS_LIST) + (F.wave * G_EPL + g) * GS_SEG;
            const unsigned char* hbase = HQ + (tb0 + F.wave * 16) * DM;
#define GA_HN_DMA(c_, buf_) do { int lz_ = lane; asm volatile("" : "+v"(lz_)); const unsigned ho_ = (unsigned)((lz_ >> 3) * DM + 16 * (lz_ & 7)); _Pragma("unroll") for (int r_ = 0; r_ < 2; ++r_) \
        __builtin_amdgcn_global_load_lds((const unsigned*)(hbase + (size_t)(r_ * 8 * DM + (c_) * GCH) + ho_), (LAS unsigned*)(hnb + (buf_) * 16384 + (F.wave * 2 + r_) * 1024), 16, 0, 0); } while (0)
            if (STAGE == 2) {
#pragma unroll
            for (int j = 0; j < 8; ++j) *(LAS u32x4*)(F.lds + GS_ACT + (j * NTHREADS + F.tid) * 16) = (u32x4){0u, 0u, 0u, 0u};
            GA_HN_DMA(0, 0);
            asm volatile("s_waitcnt vmcnt(0) lgkmcnt(0)" ::: "memory"); __builtin_amdgcn_s_barrier(); asm volatile("" ::: "memory");
            LAS int* act = (LAS int*)(F.lds + GS_ACT);
            GTaskA A, B;
            const unsigned i16 = 16u * (unsigned)i;
            ga_issue<PM>(A, EU, lq, i16);
            for (int c = 0; c < GNCH; ++c) {
                const unsigned char* tc = EU + (size_t)c * NEXP * GCH;
                const unsigned char* tn = EU + (size_t)(c + 1 < GNCH ? c + 1 : c) * NEXP * GCH;
                const unsigned hb = (unsigned)(GS_HN + (c & 1) * 16384 + 16 * i);
                if (c + 1 < GNCH) GA_HN_DMA(c + 1, (c + 1) & 1);
                for (int j = 0; j < G_TPW; j += 2) {
                    __builtin_amdgcn_s_setprio(2);
                    ga_issue<PM>(B, tc, lq + 16 * (j + 1), i16);
                    __builtin_amdgcn_s_setprio(0);
                    ga_compute<PM>(A, hb, lq + 16 * j, act, i, lane);
                    __builtin_amdgcn_s_setprio(2);
                    if (j + 2 < G_TPW) ga_issue<PM>(A, tc, lq + 16 * (j + 2), i16); else ga_issue<PM>(A, tn, lq, i16);
                    __builtin_amdgcn_s_setprio(0);
                    ga_compute<PM>(B, hb, lq + 16 * (j + 1), act, i, lane);
                }
                asm volatile("s_waitcnt vmcnt(16) lgkmcnt(0)" ::: "memory"); __builtin_amdgcn_s_barrier(); asm volatile("" ::: "memory");
            }
#undef GA_HN_DMA
            asm volatile("" :: "v"(A.ld[0]));
            return; }
            {
                const LAS unsigned* listp = (const LAS unsigned*)(F.lds + GS_LIST);
                LAS int* acti = (LAS int*)(F.lds + GS_ACT);
                LAS bf16_t* svt = (LAS bf16_t*)(F.lds + GS_HN);
                const float* SCU = (const float*)(F.ws + WS_ESC); const float* SCV = SCU + NEXP;
                {
                    unsigned en[32]; float us[32], vs[32];
#pragma unroll
                    for (int k = 0; k < 32; ++k) en[k] = listp[k * NTHREADS + F.tid];
#pragma unroll
                    for (int k = 0; k < 32; ++k) { const unsigned e = en[k] >> 14; us[k] = SCU[e]; vs[k] = SCV[e]; }
#pragma unroll
                    for (int k = 0; k < 32; ++k) { const unsigned slot = en[k] & 0x3fffu; const int ai = acti[slot]; const float af = (float)ai * us[k];
                        acti[slot] = __builtin_bit_cast(int, af); svt[slot] = (bf16_t)f2bf(vs[k]); }
                }
            }
            asm volatile("s_waitcnt lgkmcnt(0)" ::: "memory"); __builtin_amdgcn_s_barrier(); asm volatile("" ::: "memory");
        }
}
template <int MODE, int STAGE>
__device__ __forceinline__ void gather_block(const Ctx& F, const Args& a, int l, int tb) {
    const unsigned char* EU = F.ws + WS_EU; const unsigned char* EV = F.ws + WS_EV;
    const unsigned short* EID = (const unsigned short*)(F.ws + WS_EID); const bf16_t* GATE = (const bf16_t*)(F.ws + WS_GATE);
    unsigned char* HQ = F.ws + WS_H; float* HSC = (float*)(F.ws + WS_HSC);
    bf16_t* X = (bf16_t*)(F.ws + WS_XB);
    const float* gnext = (l + 1 < NLAYER) ? a.in[6] + (l + 1) * DM : a.in[21];
    if (MODE == 4) return;
    const int lane = F.lane, g = lane / G_LPP, i = lane % G_LPP;
    LAS unsigned char* wl = F.lds + F.wave * G_WAVE_LDS;
    LAS int* wact = (LAS int*)(F.lds + GS_ACT + F.wave * 8192);
    const LAS float* wactf = (const LAS float*)wact; const LAS bf16_t* wsv = (const LAS bf16_t*)(F.lds + GS_HN) + F.wave * (G_TPW * PSEL);
    LAS unsigned short* wids = (LAS unsigned short*)wl;
    LAS unsigned char* wq = wl + 4096;
    LAS float* wsc = (LAS float*)(wl + 4096 + 2048);
    {
        const int tg = tb * NWAVES + F.wave;
        const size_t t0 = (size_t)tg * G_TPW;
        if (STAGE == 1) {
        constexpr int WR = 16;
        for (int mb = 0; mb < G_TPW; mb += WR) {
            int ex[WR][2]; float gt[WR][2], hs[WR];
#pragma unroll
            for (int r = 0; r < WR; ++r) { hs[r] = HSC[t0 + mb + r];
#pragma unroll
                for (int hh = 0; hh < 2; ++hh) { ex[r][hh] = (int)EID[(t0 + mb + r) * PSEL + 64 * hh + lane]; gt[r][hh] = __builtin_bit_cast(float, (unsigned)GATE[(t0 + mb + r) * PSEL + 64 * hh + lane] << 16); } }
#pragma unroll
            for (int r = 0; r < WR; ++r) {
                const int m = mb + r;
                float wv[2]; float mx = 0.f;
#pragma unroll
                for (int hh = 0; hh < 2; ++hh) {
                    const int e = 64 * hh + lane, eg = e % G_EPL, ek = e / G_EPL;
                    wids[(m * G_EPL + eg) * G_NLD + ek] = (unsigned short)ex[r][hh];
                    const float act = wactf[m * PSEL + e] * hs[r];
                    wv[hh] = gt[r][hh] * gelu1(act) * __builtin_bit_cast(float, (unsigned)wsv[m * PSEL + e] << 16);
                    mx = fmaxf(mx, fabsf(wv[hh]));
                }
                mx = wave_max(mx);
                const float sc = mx > 0.f ? mx * (1.f / 127.f) : 1.f, is = 1.f / sc;
#pragma unroll
                for (int hh = 0; hh < 2; ++hh) {
                    const int e = 64 * hh + lane, eg = e % G_EPL, ek = e / G_EPL;
                    wq[(m * G_EPL + eg) * G_NLD + ek] = (unsigned char)((int)rintf(wv[hh] * is) & 255);
                }
                if (lane == 0) wsc[m] = sc;
            }
        }
        asm volatile("s_waitcnt lgkmcnt(0)" ::: "memory");
        }
        if (STAGE == 2) {
        {
            GTask A, B;
            g_issue<true, MODE>(A, EV, HQ, X, wids, 0, 0, t0, g, i);
            for (int c = 0; c < GNCH; ++c) {
                for (int m = 0; m < G_TPW; m += 2) {
                    __builtin_amdgcn_s_setprio(2);
                    g_issue<true, MODE>(B, EV, HQ, X, wids, c, m + 1, t0, g, i);
                    __builtin_amdgcn_s_setprio(0);
                    g_compute_b<MODE>(A, wq, wsc, X, c, m, t0, g, i, lane);
                    __builtin_amdgcn_s_setprio(2);
                    { const int m2 = (m + 2 < G_TPW) ? m + 2 : 0, c2 = (m + 2 < G_TPW) ? c : (c + 1 < GNCH ? c + 1 : c);
                      g_issue<true, MODE>(A, EV, HQ, X, wids, c2, m2, t0, g, i); }
                    __builtin_amdgcn_s_setprio(0);
                    g_compute_b<MODE>(B, wq, wsc, X, c, m + 1, t0, g, i, lane);
                }
            }
            asm volatile("" :: "v"(A.ld[0]));
        }
        }
        if (MODE != 0 || STAGE != 3) return;
        asm volatile("s_waitcnt vmcnt(0)" ::: "memory");
        {
            u32x4 xr[G_TPW][2];
#pragma unroll
            for (int r = 0; r < G_TPW; ++r)
#pragma unroll
                for (int q = 0; q < 2; ++q) xr[r][q] = __builtin_nontemporal_load((const u32x4*)(X + (t0 + r) * DM + 512 * q + 8 * lane));
            __builtin_amdgcn_sched_barrier(0);
#pragma unroll
            for (int r = 0; r < G_TPW; ++r) {
                const int m = r;
                float vv[16];
#pragma unroll
                for (int q = 0; q < 2; ++q)
#pragma unroll
                    for (int k = 0; k < 4; ++k) { vv[8 * q + 2 * k] = bflo(xr[r][q][k]); vv[8 * q + 2 * k + 1] = bfhi(xr[r][q][k]); }
                rms_inplace16(vv, gnext, lane);
                if (l + 1 < NLAYER) store_i8_row16(vv, HQ + (t0 + m) * DM, HSC + t0 + m, lane);
                else {
                    float* orow = a.out + (t0 + m) * DM;
#pragma unroll
                    for (int q = 0; q < 2; ++q) { *(f32x4*)(orow + 512 * q + 8 * lane) = (f32x4){vv[8 * q], vv[8 * q + 1], vv[8 * q + 2], vv[8 * q + 3]};
                        *(f32x4*)(orow + 512 * q + 8 * lane + 4) = (f32x4){vv[8 * q + 4], vv[8 * q + 5], vv[8 * q + 6], vv[8 * q + 7]}; }
                }
            }
        }
    }
}

constexpr int PH_PER_LAYER = 8, NPHASE = 2 + NLAYER * PH_PER_LAYER;
#ifndef PMASK
#define PMASK 0xFFFF
#endif
#define PM(j) ((PMASK >> (j)) & 1)
#ifndef PROBE_PH
#define PROBE_PH -1
#endif
#ifndef PROBE_REPS
#define PROBE_REPS 1
#endif
#define NREP(k) ((PROBE_PH == (k)) ? 1 + PROBE_REPS : 1)
__global__ void __launch_bounds__(NTHREADS, 2) fwd(Args a) {
    extern __shared__ __attribute__((aligned(16))) unsigned char lds_raw[];
    volatile LAS unsigned* MISC = (volatile LAS unsigned*)((LAS unsigned char*)lds_raw + MISC_OFF);
    const int wv = __builtin_amdgcn_readfirstlane((int)threadIdx.x >> 6);
    if (threadIdx.x < 32) MISC[threadIdx.x] = 0u;
    __syncthreads();
#ifndef MK_SINGLE
#define MK_SINGLE 1
#endif
    const bool single = MK_SINGLE ? true : (a.ph_hi - a.ph_lo) > 1;
    XcdBarrier bar; bar.bar = (unsigned*)(a.ws + WS_CTL); bar.x = 0; bar.st = MISC + 8; bar.wv = wv;
    if (single) bar = xcd_barrier_post((unsigned*)(a.ws + WS_CTL), MISC + 8, wv);
    const int lo = a.ph_lo, hi = a.ph_hi;
#define IN(k) (MK_SINGLE ? true : (lo <= (k) && (k) < hi))
#ifndef PROBE_BAR
#define PROBE_BAR 0
#endif
#define SEAM(k) do { if (IN(k) && IN((k) + 1)) { xcd_barrier(bar); if (PROBE_BAR) xcd_barrier(bar); } } while (0)

    if (PM(15) && IN(0)) { MKCTX(F, a); p0a_stream(F, a, 4 | 8 | 16); }
    SEAM(0);
    if (PM(15) && IN(1)) { MKCTX(F, a); p0_main(F, a); }
    SEAM(1);
    for (int l = 0; l < NLAYER; ++l) {
        const int pb = 2 + l * PH_PER_LAYER;
        if (PM(0) && IN(pb + 0)) for (int rep = 0; rep < NREP(0); ++rep) {
            MKCTX(F, a);
            const bool cvt_here = l > 0 || gridDim.x == 256, cvt_first = !(F.bid & 1) || gridDim.x != 256;
            if (cvt_here && cvt_first) convert_experts(F, a, l);
            pg8::Gemm g{(const bf16_t*)(F.ws + WS_H), (const bf16_t*)(F.ws + WS_WIN + (size_t)l * 2048 * DM), DM / 2, DM / 2, DM / 2};
            pg8::StaticOrder S; S.init(TOK, 2048, F.G, F.bid);
            EpiQKVU<true> E{(bf16_t*)(F.ws + WS_Q), (bf16_t*)(F.ws + WS_K), (bf16_t*)(F.ws + WS_V), (bf16_t*)(F.ws + WS_UX), (const float*)(F.ws + WS_HSC), (const float*)(F.ws + WS_WSC) + WSC_IN + l * 2048};
            if (stage_scales(F.lds, F.wave, F.lane, S, E.rs, E.cs)) pg8::gemm_phase(F.lds, F.tid, g, S, E);
            else { EpiQKVU<false> E2{E.Q, E.Kp, E.V, E.UX, E.rs, E.cs}; pg8::gemm_phase(F.lds, F.tid, g, S, E2); }
            if (cvt_here && !cvt_first) { MKCTX(F2, a); convert_experts(F2, a, l); }
        }
        SEAM(pb + 0);
#ifndef ATT_A
#define ATT_A 5
#endif
#ifndef PROBE_P1
#define PROBE_P1 0
#endif
        if (PM(1) && IN(pb + 1)) for (int rep = 0; rep < NREP(1); ++rep) {
            if (!(PROBE_P1 == 1 && rep < NREP(1) - 1)) {
              { MKCTX(F, a);
                pg8::Gemm g{(const bf16_t*)(F.ws + WS_UX), (const bf16_t*)(F.ws + WS_W1) + (size_t)l * SG * N1 * K1, K2, K1, K1};
                pg8::BatchOrder S; S.init(ROWS_G / 256, N1 / 256, SG, F.G, F.bid);
                EpiE E{(float*)(F.ws + WS_E)};
                pg8::gemm_phase(F.lds, F.tid, g, S, E);
                asm volatile("s_waitcnt vmcnt(0)" ::: "memory");
                __syncthreads();
                for (int L = F.bid; L < SG * 4; L += F.G) carry_unit(F, a, l, L >> 2, L & 3);
                asm volatile("s_waitcnt vmcnt(0)" ::: "memory");
                __syncthreads();
              }
              { MKCTX(F, a);
                pg8::Gemm g{(const bf16_t*)(F.ws + WS_UX), (const bf16_t*)(F.ws + WS_M2) + (size_t)l * SG * N2 * K2, K2, K2, K2};
                pg8::LocalPairOrder S; S.init(F.G, F.bid);
                EpiY E{(bf16_t*)(F.ws + WS_Y)};
                pg8::gemm_phase(F.lds, F.tid, g, S, E);
              }
            }
            if (!(PROBE_P1 == 2 && rep < NREP(1) - 1)) { MKCTX(F, a);
              { MKCTX(F2, a); attn_table(F2, a); }
              attn_phase(F, a, (unsigned*)(F.ws + WS_AQ) + l * 64);
            }
        }
        SEAM(pb + 1);
        if (PM(2) && IN(pb + 2)) for (int rep = 0; rep < NREP(2); ++rep) {
            MKCTX(F, a);
            pg8::Gemm g{(const bf16_t*)(F.ws + WS_Y), (const bf16_t*)(F.ws + WS_WGLU) + (size_t)l * 1024 * SW, SW, SW, SW};
            pg8::StaticOrder S; S.init(TOK, 1024, F.G, F.bid);
            EpiGLU E{(bf16_t*)(F.ws + WS_SSM)};
            pg8::gemm_phase(F.lds, F.tid, g, S, E);
        }
        SEAM(pb + 2);
        if (PM(3) && IN(pb + 3)) for (int rep = 0; rep < NREP(3); ++rep) { MKCTX(F, a); mixprep_phase(F, a, l); }
        SEAM(pb + 3);
        if (PM(4) && IN(pb + 4)) for (int rep = 0; rep < NREP(4); ++rep) {
            MKCTX(F, a);
            pg8::Gemm g{(const bf16_t*)(F.ws + WS_H), (const bf16_t*)(F.ws + WS_WOUT + (size_t)l * DM * DM), DM / 2, DM / 2, DM / 2};
            pg8::StaticOrder S; S.init(TOK, DM, F.G, F.bid);
            EpiRes<true> E{(bf16_t*)(F.ws + WS_XB), (const float*)(F.ws + WS_HSC), (const float*)(F.ws + WS_WSC) + WSC_OUT + l * DM, rep == NREP(4) - 1};
            if (l == 0 && gridDim.x == 256) {
                EpiResF<true> EF{a.in[0], E.X, E.rs, E.cs};
                (void)stage_scales(F.lds, F.wave, F.lane, S, E.rs, E.cs);
                pg8::gemm_phase(F.lds, F.tid, g, S, EF);
            }
            else if (stage_scales(F.lds, F.wave, F.lane, S, E.rs, E.cs)) pg8::gemm_phase(F.lds, F.tid, g, S, E);
            else { EpiRes<false> E2{E.X, E.rs, E.cs, E.store}; pg8::gemm_phase(F.lds, F.tid, g, S, E2); }
        }
        SEAM(pb + 4);
        if (PM(5) && IN(pb + 5)) for (int rep = 0; rep < NREP(5); ++rep) {
            MKCTX(F, a);
            for (int m = (F.bid * NWAVES + F.wave) * 4; m < TOK; m += F.G * NWAVES * 4) rms_xb_rows_to_i8<4>((const bf16_t*)(F.ws + WS_XB) + (size_t)m * DM, a.in[7] + l * DM, F.ws + WS_H + (size_t)m * DM, (float*)(F.ws + WS_HSC) + m, F.lane);
        }
        SEAM(pb + 5);
        if (PM(6) && IN(pb + 6)) for (int rep = 0; rep < NREP(6); ++rep) {
            MKCTX(F, a);
            pg8::Gemm g{(const bf16_t*)(F.ws + WS_H), (const bf16_t*)(F.ws + WS_WQ + (size_t)l * DM * DM), DM / 2, DM / 2, DM / 2};
            pg8::StaticOrder S; S.init(TOK, DM, F.G, F.bid);
            EpiBf<true> E{(bf16_t*)(F.ws + WS_QB), DM, (const float*)(F.ws + WS_HSC), (const float*)(F.ws + WS_WSC) + WSC_Q + l * DM};
            if (stage_scales(F.lds, F.wave, F.lane, S, E.rs, E.cs)) pg8::gemm_phase(F.lds, F.tid, g, S, E);
            else { EpiBf<false> E2{E.O, E.ldc, E.rs, E.cs}; pg8::gemm_phase(F.lds, F.tid, g, S, E2); }
        }
        SEAM(pb + 6);
        if (PM(7) && IN(pb + 7)) for (int rep = 0; rep < NREP(7); ++rep) {
            for (int tb = blockIdx.x; tb < TOK / 128; tb += gridDim.x) {
                { MKCTX(F, a); topk_block(F, a, l, tb); }
                asm volatile("s_waitcnt vmcnt(0)" ::: "memory");
                __syncthreads();
                { MKCTX(F, a); gather_a<0, 1>(F, a, tb); }
                { MKCTX(F, a); gather_a<0, 2>(F, a, tb); }
                { MKCTX(F, a); gather_a<0, 3>(F, a, tb); }
                { MKCTX(F, a); gather_block<0, 1>(F, a, l, tb); }
                { MKCTX(F, a); gather_block<0, 2>(F, a, l, tb); }
                { MKCTX(F, a); gather_block<0, 3>(F, a, l, tb); }
                __syncthreads();
                if (wv == 0 && lane_id() < 32) MISC[lane_id()] = 0u;
            }
        }
        SEAM(pb + 7);
    }
#undef IN
#undef SEAM
}

static int t5_bucket(int rel) {
    const int half = 16, max_exact = 8;
    const int n = rel < 0 ? -rel : rel;
    int large = max_exact + (int)(std::log((double)(n > 1 ? n : 1) / (double)max_exact) / std::log(1024.0 / (double)max_exact) * (double)(half - max_exact));
    if (large > half - 1) large = half - 1;
    return (rel > 0 ? half : 0) + (n < max_exact ? n : large);
}

extern "C" void kernel_launch(void* const* d_in, const int* in_sizes, int n_in, void* d_out, int out_size, void* d_ws, size_t ws_size, hipStream_t stream) {
    static int grid = 0;
    if (grid == 0) {
        if (n_in != 22 || out_size != TOK * DM || ws_size < WS_END) { fprintf(stderr, "kernel_launch: unexpected shapes (n_in %d out %d ws %zu)\n", n_in, out_size, ws_size); grid = -1; return; }
        int dev = 0, cus = 0, per_cu = 0;
        if (hipGetDevice(&dev) != hipSuccess || hipDeviceGetAttribute(&cus, hipDeviceAttributeMultiprocessorCount, dev) != hipSuccess) { grid = -1; return; }
        if (hipFuncSetAttribute((const void*)fwd, hipFuncAttributeMaxDynamicSharedMemorySize, LDS_BYTES) != hipSuccess) { fprintf(stderr, "kernel_launch: hipFuncSetAttribute failed\n"); grid = -1; return; }
        if (hipOccupancyMaxActiveBlocksPerMultiprocessor(&per_cu, (const void*)fwd, NTHREADS, LDS_BYTES) != hipSuccess || per_cu < 1) fprintf(stderr, "kernel_launch: occupancy query says %d\n", per_cu);
        (void)hipGetLastError();
        grid = cus;
    }
    if (grid < 0) return;
    hipMemsetAsync((char*)d_ws + WS_CTL, 0, CTL_ZERO_BYTES, stream);
    Args a; memset(&a, 0, sizeof(a));
    for (int i = 0; i < 22; ++i) a.in[i] = (const float*)d_in[i];
    a.out = (float*)d_out; a.ws = (unsigned char*)d_ws;
    for (int p = 0; p < 3; ++p) { const int d = p == 0 ? 1 : (p == 1 ? 4 : 16); for (int i = 0; i < 129; ++i) a.bkt[p][i] = (signed char)t5_bucket((i - 64) * d); }
#ifndef MK_SINGLE
#define MK_SINGLE 1
#endif
    if (MK_SINGLE) {
        a.ph_lo = 0; a.ph_hi = NPHASE;
        hipLaunchKernelGGL(fwd, dim3(grid), dim3(NTHREADS), LDS_BYTES, stream, a);
    } else {
        for (int ph = 0; ph < NPHASE; ++ph) { a.ph_lo = ph; a.ph_hi = ph + 1; hipLaunchKernelGGL(fwd, dim3(grid), dim3(NTHREADS), LDS_BYTES, stream, a); }
    }
}
```
